# Optimizing an MI355X kernel written in HIP

```python
import math
import jax, jax.numpy as jnp
from jax import lax
import numpy as np


D_MODEL = 1024
BATCH = 16
SEQ = 4096
DEPTH = 2
DEC_BATCH = 2
DEC_SEQ = 16384
PAST_LEN = 128

GRID_W = 64
NA_HEADS = 16
NA_HEAD_DIM = D_MODEL // NA_HEADS
NA_KH_MAX = 8
NA_KW = 16
NA_QCB = NA_KW
NA_KCB = 2 * NA_KW
DIFF_HEAD_DIM = 64
DIFF_HEADS = D_MODEL // (2 * DIFF_HEAD_DIM)
Q_BLOCK = 128
T5_BUCKETS = 32
T5_MAX_DIST = 128
D_FF = -(-(8 * D_MODEL) // (3 * 256)) * 256
N_NA_LAYERS = (DEPTH + 1) // 2
N_DIFF_LAYERS = DEPTH // 2
RMS_EPS = 1e-6
NEG_INF = -1e30

kernel_name = "hybrid_natten_diffattn_encoder"


def rms_norm(x, g):
    xf = x.astype(jnp.float32)
    y = xf * lax.rsqrt(jnp.mean(xf * xf, axis=-1, keepdims=True) + RMS_EPS)
    return (y * g.astype(jnp.float32)).astype(x.dtype)


def swiglu(x, w_gate, w_up, w_down):
    return (jax.nn.silu(x @ w_gate) * (x @ w_up)) @ w_down


def neighborhood_attention(x, w_qkv, w_o, rpb):
    b, s, _ = x.shape
    rows = s // GRID_W
    kh = min(NA_KH_MAX, rows)
    ncb = GRID_W // NA_QCB
    qkv = (x @ w_qkv).reshape(b, rows, GRID_W, 3, NA_HEADS, NA_HEAD_DIM)
    q = qkv[:, :, :, 0] * (NA_HEAD_DIM ** -0.5)
    k = qkv[:, :, :, 1]
    v = qkv[:, :, :, 2]
    r = jnp.arange(rows)
    row0 = jnp.clip(r - kh // 2, 0, rows - kh)
    key_rows = row0[:, None] + jnp.arange(kh)[None, :]
    dr_idx = key_rows - r[:, None] + (NA_KH_MAX - 1)
    j = jnp.arange(ncb)
    q_cols = j[:, None] * NA_QCB + jnp.arange(NA_QCB)[None, :]
    col0 = jnp.clip(j * NA_QCB - NA_KW // 2, 0, GRID_W - NA_KCB)
    k_cols = col0[:, None] + jnp.arange(NA_KCB)[None, :]
    q_start = jnp.clip(q_cols - NA_KW // 2, 0, GRID_W - NA_KW)
    kc = k_cols[:, None, :]
    in_win = (kc >= q_start[:, :, None]) & (kc < q_start[:, :, None] + NA_KW)
    dc_idx = jnp.clip(kc - q_cols[:, :, None] + (NA_KW - 1), 0, 2 * NA_KW - 2)
    rpb_f = rpb.astype(jnp.float32)

    def row_step(args):
        q_r, rows_r, dr_r = args
        k_blk = k[:, rows_r[:, None, None], k_cols[None, :, :]]
        v_blk = v[:, rows_r[:, None, None], k_cols[None, :, :]]
        bias = rpb_f[:, dr_r][:, :, dc_idx]
        bias = jnp.transpose(bias, (0, 2, 3, 1, 4))
        bias = jnp.where(in_win[:, :, None, :], bias, NEG_INF)
        sc = jnp.einsum('bjqhd,bkjchd->bhjqkc', q_r, k_blk).astype(jnp.float32) + bias
        p = jax.nn.softmax(sc.reshape(b, NA_HEADS, ncb, NA_QCB, kh * NA_KCB), axis=-1)
        p = p.reshape(sc.shape).astype(v.dtype)
        return jnp.einsum('bhjqkc,bkjchd->bjqhd', p, v_blk)

    q_rows = jnp.moveaxis(q.reshape(b, rows, ncb, NA_QCB, NA_HEADS, NA_HEAD_DIM), 1, 0)
    out = lax.map(row_step, (q_rows, key_rows, dr_idx))
    out = jnp.moveaxis(out, 0, 1).reshape(b, s, D_MODEL)
    return out @ w_o


def t5_bucket(rel):
    nb = T5_BUCKETS // 2
    max_exact = nb // 2
    ret = jnp.where(rel > 0, nb, 0)
    n = jnp.abs(rel)
    nf = jnp.maximum(n, max_exact).astype(jnp.float32)
    large = max_exact + (jnp.log(nf / max_exact) / math.log(T5_MAX_DIST / max_exact)
                         * (nb - max_exact)).astype(jnp.int32)
    large = jnp.minimum(large, nb - 1)
    return ret + jnp.where(n < max_exact, n, large)


def diff_attention(x, w_qkv, w_o, lq1, lk1, lq2, lk2, subln_g, t5_bias, lambda_init):
    b, s, _ = x.shape
    nblk = s // Q_BLOCK
    q, k, v = jnp.split(x @ w_qkv, 3, axis=-1)
    q = (q * DIFF_HEAD_DIM ** -0.5).reshape(b, nblk, Q_BLOCK, DIFF_HEADS, 2, DIFF_HEAD_DIM)
    qb = jnp.transpose(q, (1, 4, 0, 3, 2, 5))
    k = k.reshape(b, s, DIFF_HEADS, 2, DIFF_HEAD_DIM)
    k1 = jnp.transpose(k[:, :, :, 0], (0, 2, 1, 3))
    k2 = jnp.transpose(k[:, :, :, 1], (0, 2, 1, 3))
    v = jnp.transpose(v.reshape(b, s, DIFF_HEADS, 2 * DIFF_HEAD_DIM), (0, 2, 1, 3))
    f32 = jnp.float32
    lam = (jnp.exp(jnp.sum(lq1.astype(f32) * lk1.astype(f32)))
           - jnp.exp(jnp.sum(lq2.astype(f32) * lk2.astype(f32))) + lambda_init)
    k_pos = jnp.arange(s)
    table = t5_bias.astype(f32)

    def blk_step(args):
        q_blk, i = args
        q_pos = i * Q_BLOCK + jnp.arange(Q_BLOCK)
        bias = jnp.transpose(table[t5_bucket(k_pos[None, :] - q_pos[:, None])], (2, 0, 1))
        a1 = jax.nn.softmax(jnp.einsum('bhqd,bhkd->bhqk', q_blk[0], k1).astype(f32) + bias, axis=-1)
        a2 = jax.nn.softmax(jnp.einsum('bhqd,bhkd->bhqk', q_blk[1], k2).astype(f32) + bias, axis=-1)
        w = (a1 - lam * a2).astype(v.dtype)
        return jnp.einsum('bhqk,bhke->bhqe', w, v)

    out = lax.map(blk_step, (qb, jnp.arange(nblk)))
    out = rms_norm(out, subln_g) * (1.0 - lambda_init)
    out = jnp.transpose(out, (1, 0, 3, 2, 4)).reshape(b, s, D_MODEL)
    return out @ w_o


def encoder_trunk(x, mix_pre_g, mix_post_g, na_w_qkv, na_w_o, na_rpb, diff_w_qkv, diff_w_o,
                  diff_lambda_q1, diff_lambda_k1, diff_lambda_q2, diff_lambda_k2, diff_subln_g,
                  t5_bias, ffn_pre_g, ffn_post_g, ffn_w_gate, ffn_w_up, ffn_w_down):
    for i in range(DEPTH):
        h = rms_norm(x, mix_pre_g[i])
        li = i // 2
        if i % 2 == 0:
            m = neighborhood_attention(h, na_w_qkv[li], na_w_o[li], na_rpb[li])
        else:
            lambda_init = 0.8 - 0.6 * math.exp(-0.3 * i)
            m = diff_attention(h, diff_w_qkv[li], diff_w_o[li], diff_lambda_q1[li], diff_lambda_k1[li],
                               diff_lambda_q2[li], diff_lambda_k2[li], diff_subln_g[li], t5_bias, lambda_init)
        x = x + rms_norm(m, mix_post_g[i])
        h = rms_norm(x, ffn_pre_g[i])
        x = x + rms_norm(swiglu(h, ffn_w_gate[i], ffn_w_up[i], ffn_w_down[i]), ffn_post_g[i])
    return x


def setup_inputs(seed: int = 0) -> dict:
    key = jax.random.key(seed)
    ks = jax.random.split(key, 20)
    n = jax.random.normal
    f32 = jnp.float32
    D = D_MODEL
    return {
        "x_prompt": n(ks[0], (BATCH, SEQ, D), f32),
        "x_sample": n(ks[1], (DEC_BATCH, DEC_SEQ, D), f32),
        "mix_pre_g": 1.0 + 0.05 * n(ks[2], (DEPTH, D), f32),
        "mix_post_g": 1.0 + 0.05 * n(ks[3], (DEPTH, D), f32),
        "na_w_qkv": n(ks[4], (N_NA_LAYERS, D, 3 * D), f32) * D ** -0.5,
        "na_w_o": n(ks[5], (N_NA_LAYERS, D, D), f32) * D ** -0.5,
        "na_rpb": 0.2 * n(ks[6], (N_NA_LAYERS, NA_HEADS, 2 * NA_KH_MAX - 1, 2 * NA_KW - 1), f32),
        "diff_w_qkv": n(ks[7], (N_DIFF_LAYERS, D, 3 * D), f32) * D ** -0.5,
        "diff_w_o": n(ks[8], (N_DIFF_LAYERS, D, D), f32) * D ** -0.5,
        "diff_lambda_q1": 0.1 * n(ks[9], (N_DIFF_LAYERS, DIFF_HEAD_DIM), f32),
        "diff_lambda_k1": 0.1 * n(ks[10], (N_DIFF_LAYERS, DIFF_HEAD_DIM), f32),
        "diff_lambda_q2": 0.1 * n(ks[11], (N_DIFF_LAYERS, DIFF_HEAD_DIM), f32),
        "diff_lambda_k2": 0.1 * n(ks[12], (N_DIFF_LAYERS, DIFF_HEAD_DIM), f32),
        "diff_subln_g": 1.0 + 0.05 * n(ks[13], (N_DIFF_LAYERS, 2 * DIFF_HEAD_DIM), f32),
        "t5_bias": 0.2 * n(ks[14], (T5_BUCKETS, DIFF_HEADS), f32),
        "ffn_pre_g": 1.0 + 0.05 * n(ks[15], (DEPTH, D), f32),
        "ffn_post_g": 1.0 + 0.05 * n(ks[16], (DEPTH, D), f32),
        "ffn_w_gate": n(ks[17], (DEPTH, D, D_FF), f32) * D ** -0.5,
        "ffn_w_up": n(ks[18], (DEPTH, D, D_FF), f32) * D ** -0.5,
        "ffn_w_down": n(ks[19], (DEPTH, D_FF, D), f32) * D_FF ** -0.5,
    }


def reference(x_prompt, x_sample, mix_pre_g, mix_post_g, na_w_qkv, na_w_o, na_rpb, diff_w_qkv, diff_w_o,
              diff_lambda_q1, diff_lambda_k1, diff_lambda_q2, diff_lambda_k2, diff_subln_g, t5_bias,
              ffn_pre_g, ffn_post_g, ffn_w_gate, ffn_w_up, ffn_w_down):
    y_prompt = encoder_trunk(x_prompt, mix_pre_g, mix_post_g, na_w_qkv, na_w_o, na_rpb, diff_w_qkv, diff_w_o,
                             diff_lambda_q1, diff_lambda_k1, diff_lambda_q2, diff_lambda_k2, diff_subln_g,
                             t5_bias, ffn_pre_g, ffn_post_g, ffn_w_gate, ffn_w_up, ffn_w_down)
    y_sample = encoder_trunk(x_sample, mix_pre_g, mix_post_g, na_w_qkv, na_w_o, na_rpb, diff_w_qkv, diff_w_o,
                             diff_lambda_q1, diff_lambda_k1, diff_lambda_q2, diff_lambda_k2, diff_subln_g,
                             t5_bias, ffn_pre_g, ffn_post_g, ffn_w_gate, ffn_w_up, ffn_w_down)
    return (y_prompt, y_sample)
```

```cpp
#include <hip/hip_runtime.h>
#include <hip/hip_cooperative_groups.h>
#include <hip/hip_bf16.h>
#include <cstdio>
#include <cstdint>
namespace cg = cooperative_groups;
namespace pg8 {
#define PG8_LAS __attribute__((address_space(3)))
typedef unsigned short bf16_t;
typedef short bf16x8 __attribute__((ext_vector_type(8)));
typedef float f32x4 __attribute__((ext_vector_type(4)));
typedef unsigned u32x4 __attribute__((ext_vector_type(4)));
constexpr int BM = 256, BK = 64, HALF = 128, HTB = HALF * BK * 2  , STAGE_BYTES = 8 * HTB, NXCD = 8, WGM = 8;

__host__ __device__ __forceinline__ int lds_byte(int r, int c) { const int st = (r >> 4) * 2 + (c >> 5), rr = r & 15, cc = c & 31, ob = rr * 64 + cc * 2; return st * 1024 + (ob ^ (((ob >> 9) & 1) << 5)); }
__host__ __device__ __forceinline__ void stage_rc(int b, int& R, int& C) { const int st = b / 1024, sb = b % 1024, swz = sb ^ (((sb >> 9) & 1) << 5); R = (st >> 1) * 16 + swz / 64; C = (st & 1) * 32 + (swz % 64) / 2; }
__host__ __device__ __forceinline__ int perm32(int rho) { const int n = rho >> 4, i = rho & 15; return 8 * (i >> 2) + 4 * n + (i & 3); }

struct Unit { int pm, pn; };
struct Gemm { const bf16_t* A; const bf16_t* Bt; int M, N, K; };

struct StaticOrder {
    int nM, nN, nwg, G, c;
    __host__ __device__ void init(int M, int N, int G_, int c_) { nM = M / BM; nN = N / BM; nwg = nM * nN; G = G_; c = c_; }
    __host__ __device__ bool next(int i, Unit& u) const {
        const long L = (long)i * G + c; if (L >= nwg) return false;
        int wgid = (int)L; { const int q = nwg / NXCD, r = nwg % NXCD, xcd = wgid % NXCD, off = wgid / NXCD; wgid = (xcd < r ? xcd * (q + 1) : r * (q + 1) + (xcd - r) * q) + off; }
        const int nig = WGM * nN, gid = wgid / nig, fm = gid * WGM, gsz = (nM - fm) < WGM ? (nM - fm) : WGM;
        u.pm = fm + ((wgid % nig) % gsz); u.pn = (wgid % nig) / gsz; return true;
    }
    __device__ __forceinline__ void a_ready(const Unit&) const {}
    __device__ __forceinline__ void done(const Unit&) const {}
};

__device__ __forceinline__ unsigned cvt_pk_bf16(float lo, float hi) { unsigned r; asm volatile("v_cvt_pk_bf16_f32 %0, %1, %2" : "=v"(r) : "v"(lo), "v"(hi)); return r; }
typedef float f32x2 __attribute__((ext_vector_type(2)));
__device__ __forceinline__ f32x2 gelu_pk(f32x2 v) {
    const f32x2 av = __builtin_elementwise_abs(v), d = av * 0.2316418882f + 1.0f;
    f32x2 t; t.x = __builtin_amdgcn_rcpf(d.x); t.y = __builtin_amdgcn_rcpf(d.y);
    f32x2 q = t * 0.5307027145f + (-0.7265760135f); q = q * t + 0.7107068705f; q = q * t + (-0.142248368f); q = q * t + 0.127414796f; q = q * t;
    const f32x2 s = (v * v) * (-0.72134752044f);
    f32x2 e; e.x = __builtin_amdgcn_exp2f(s.x); e.y = __builtin_amdgcn_exp2f(s.y);
    const f32x2 m = v * (q * e), r = v - m;
    f32x2 o; o.x = v.x < 0.f ? m.x : r.x; o.y = v.y < 0.f ? m.y : r.y; return o;
}

template <int ACT  > struct EpiBf16 {
    static constexpr bool PERM = true, AFTER_DRAIN = false; static_assert(ACT == 0 || ACT == 1, "EpiBf16: ACT is 0 (none) or 1 (gelu_pk)");
    bf16_t* O; int ldc; const float* bias; int split_cols; size_t split_stride; float scale0;
    __device__ __forceinline__ void operator()(const f32x4 (&acc)[2][2][4][2], const Unit& u, int wr, int wc, int fr, int fq) const {
        const int row0 = u.pm * BM + wr * 64 + fr; int colt = u.pn * BM; bf16_t* base = O;
        float sc = 1.f; if (split_cols) { const int t = colt / split_cols; base += (size_t)t * split_stride; colt -= t * split_cols; if (t == 0) sc = scale0; }
        const int col0 = colt + wc * 32 + 8 * fq, bcol0 = u.pn * BM + wc * 32 + 8 * fq;
        f32x4 bv[2][2];
#pragma unroll
        for (int bj = 0; bj < 2; ++bj)
#pragma unroll
            for (int n = 0; n < 2; ++n) bv[bj][n] = bias ? *(const f32x4*)(bias + bcol0 + bj * HALF + 4 * n) : (f32x4){0.f, 0.f, 0.f, 0.f};
#pragma unroll
        for (int ai = 0; ai < 2; ++ai)
#pragma unroll
            for (int m = 0; m < 4; ++m) { bf16_t* rowp = base + (size_t)(row0 + ai * HALF + m * 16) * ldc + col0;
#pragma unroll
                for (int bj = 0; bj < 2; ++bj) { f32x4 v0 = acc[ai][bj][m][0] + bv[bj][0], v1 = acc[ai][bj][m][1] + bv[bj][1];
                    if (ACT == 1) { f32x2 a = gelu_pk((f32x2){v0[0], v0[1]}), b = gelu_pk((f32x2){v0[2], v0[3]}), c = gelu_pk((f32x2){v1[0], v1[1]}), d = gelu_pk((f32x2){v1[2], v1[3]});
                        v0 = (f32x4){a.x, a.y, b.x, b.y}; v1 = (f32x4){c.x, c.y, d.x, d.y}; }
                    v0 = v0 * sc; v1 = v1 * sc; u32x4 w; w.x = cvt_pk_bf16(v0[0], v0[1]); w.y = cvt_pk_bf16(v0[2], v0[3]); w.z = cvt_pk_bf16(v1[0], v1[1]); w.w = cvt_pk_bf16(v1[2], v1[3]);
                    *(__attribute__((address_space(1))) u32x4*)(rowp + bj * HALF) = w; } }
    }
};
struct EpiSwiglu {
    static constexpr bool PERM = true, AFTER_DRAIN = false;
    bf16_t* O; int ldc; const float* rs;
    __device__ __forceinline__ void operator()(const f32x4 (&acc)[2][2][4][2], const Unit& u, int wr, int wc, int fr, int fq) const {
        const int row0 = u.pm * BM + wr * 64 + fr; const int col0 = u.pn * HALF + wc * 32 + 8 * fq;
        float scv[2][4];
#pragma unroll
        for (int ai = 0; ai < 2; ++ai)
#pragma unroll
            for (int m = 0; m < 4; ++m) scv[ai][m] = ((const __attribute__((address_space(1))) float*)rs)[row0 + ai * HALF + m * 16];
#pragma unroll
        for (int ai = 0; ai < 2; ++ai)
#pragma unroll
            for (int m = 0; m < 4; ++m) { bf16_t* rowp = O + (size_t)(row0 + ai * HALF + m * 16) * ldc + col0; const float sc = scv[ai][m];
                float v[8];
#pragma unroll
                for (int n = 0; n < 2; ++n)
#pragma unroll
                    for (int e = 0; e < 4; ++e) { const float g = acc[ai][0][m][n][e] * sc, up = acc[ai][1][m][n][e] * sc;
                        const float s = __builtin_amdgcn_rcpf(1.0f + __builtin_amdgcn_exp2f(-1.4426950408889634f * g)); v[n * 4 + e] = g * s * up; }
                u32x4 w; w.x = cvt_pk_bf16(v[0], v[1]); w.y = cvt_pk_bf16(v[2], v[3]); w.z = cvt_pk_bf16(v[4], v[5]); w.w = cvt_pk_bf16(v[6], v[7]);
                *(__attribute__((address_space(1))) u32x4*)rowp = w; }
    }
};
struct EpiQKV {
    static constexpr bool PERM = true, AFTER_DRAIN = false;
    bf16_t* O; size_t tstride; int hw_log2; int M; const float* rs;
    __device__ __forceinline__ void operator()(const f32x4 (&acc)[2][2][4][2], const Unit& u, int wr, int wc, int fr, int fq) const {
        const int row0 = u.pm * BM + wr * 64 + fr; const int colt = u.pn * BM; const int t = colt >> 10;
        bf16_t* base = O + (size_t)t * tstride; const int hw = 1 << hw_log2;
        float scv[2][4];
#pragma unroll
        for (int ai = 0; ai < 2; ++ai)
#pragma unroll
            for (int m = 0; m < 4; ++m) scv[ai][m] = ((const __attribute__((address_space(1))) float*)rs)[row0 + ai * HALF + m * 16];
#pragma unroll
        for (int bj = 0; bj < 2; ++bj) { const int col = (colt & 1023) + bj * HALF + wc * 32 + 8 * fq; const int head = col >> hw_log2, within = col & (hw - 1);
            bf16_t* hp = base + ((size_t)head * M << hw_log2) + within;
#pragma unroll
            for (int ai = 0; ai < 2; ++ai)
#pragma unroll
                for (int m = 0; m < 4; ++m) { const float sc = scv[ai][m]; const f32x4 v0 = acc[ai][bj][m][0] * sc, v1 = acc[ai][bj][m][1] * sc;
                    u32x4 w; w.x = cvt_pk_bf16(v0[0], v0[1]); w.y = cvt_pk_bf16(v0[2], v0[3]); w.z = cvt_pk_bf16(v1[0], v1[1]); w.w = cvt_pk_bf16(v1[2], v1[3]);
                    *(__attribute__((address_space(1))) u32x4*)(hp + ((size_t)(row0 + ai * HALF + m * 16) << hw_log2)) = w; } }
    }
};
template <class Epi, class Sched, bool ALIGN_EPI = false, bool SP2 = false>
__device__ __forceinline__ void gemm_phase(PG8_LAS unsigned char* lds, const Gemm g, const Sched& S, const Epi& E, int tid_in) {
    int tid_l = tid_in; asm volatile("" : "+v"(tid_l));
    const int tid = tid_l, wid = __builtin_amdgcn_readfirstlane(tid >> 6), lane = tid & 63, wr = wid >> 2, wc = wid & 3, fr = lane & 15, fq = lane >> 4;
    const int K = g.K, nt = K / BK;
    unsigned voffA[2], voffB[2];
#pragma unroll
    for (int i = 0; i < 2; ++i) { int R, C; stage_rc(tid * 16 + i * 8192, R, C); const int Rb = Epi::PERM ? ((R & ~31) + perm32(R & 31)) : R;
        voffA[i] = (unsigned)(R * K + C) * 2u; voffB[i] = (unsigned)(Rb * K + C) * 2u; }
    const size_t kstep = (size_t)(BK * 2);
    const size_t hstep = (size_t)HALF * K * 2;
    const size_t tstep = 2 * hstep;
    const unsigned ldsw = (unsigned)wid * 1024u;
    const int aoff = lds_byte(wr * 64 + fr, fq * 8), boff = lds_byte(wc * 32 + fr, fq * 8);
#define PG8_SA(b, h) (((b) * 2 + (h)) * HTB)
#define PG8_SB(b, h) ((4 + (b) * 2 + (h)) * HTB)
#define PG8_STAGE(bufoff, gbase, voff) do { _Pragma("unroll") for (int _i = 0; _i < 2; ++_i) \
        __builtin_amdgcn_global_load_lds((const unsigned*)((const char*)(gbase) + (voff)[_i]), (PG8_LAS unsigned*)(lds + (bufoff) + ldsw + _i * 8192), 16, 0, 0); } while (0)
#define PG8_LDA(dst, b, h) do { _Pragma("unroll") for (int m = 0; m < 4; ++m) _Pragma("unroll") for (int k = 0; k < 2; ++k) dst[m][k] = *(const PG8_LAS bf16x8*)(lds + PG8_SA(b, h) + aoff + m * 2048 + k * 1024); } while (0)
#define PG8_LDB(dst, b, h) do { _Pragma("unroll") for (int n = 0; n < 2; ++n) _Pragma("unroll") for (int k = 0; k < 2; ++k) dst[n][k] = *(const PG8_LAS bf16x8*)(lds + PG8_SB(b, h) + boff + n * 2048 + k * 1024); } while (0)
#define PG8_MMA(ai, bj, At, Bt) do { __builtin_amdgcn_s_setprio(1); _Pragma("unroll") for (int m = 0; m < 4; ++m) _Pragma("unroll") for (int n = 0; n < 2; ++n) _Pragma("unroll") for (int k = 0; k < 2; ++k) \
        acc[ai][bj][m][n] = __builtin_amdgcn_mfma_f32_16x16x32_bf16(Bt[n][k], At[m][k], acc[ai][bj][m][n], 0, 0, 0); __builtin_amdgcn_s_setprio(0); } while (0)
#define PG8_WAIT_V(n) asm volatile("s_waitcnt vmcnt(" #n ")" ::: "memory")
#define PG8_WAIT_L(n) asm volatile("s_waitcnt lgkmcnt(" #n ")" ::: "memory")
#define PG8_BAR __builtin_amdgcn_s_barrier()
#define PG8_SCHED __builtin_amdgcn_sched_barrier(0)
    Unit cur, nxt; int ui = 0;
    if (!S.next(0, cur)) return;
    f32x4 acc[2][2][4][2];
#pragma unroll
    for (int a = 0; a < 2; ++a)
#pragma unroll
        for (int b = 0; b < 2; ++b)
#pragma unroll
            for (int m = 0; m < 4; ++m)
#pragma unroll
                for (int n = 0; n < 2; ++n) acc[a][b][m][n] = (f32x4){0.f, 0.f, 0.f, 0.f};
    bf16x8 At[4][2], B0[2][2], B1[2][2];
    const char* cA = (const char*)g.A + (size_t)cur.pm * tstep; const char* cB = (const char*)g.Bt + (size_t)cur.pn * tstep;
    S.a_ready(cur);
    if constexpr (SP2) {
        PG8_STAGE(PG8_SB(0, 0), cB, voffB); PG8_STAGE(PG8_SB(0, 1), cB + hstep, voffB); PG8_STAGE(PG8_SA(0, 0), cA, voffA); PG8_STAGE(PG8_SA(0, 1), cA + hstep, voffA);
        if (wr == 1) PG8_BAR;
        PG8_WAIT_V(2); PG8_BAR;
        PG8_STAGE(PG8_SB(1, 0), cB + kstep, voffB); PG8_STAGE(PG8_SA(1, 0), cA + kstep, voffA); PG8_STAGE(PG8_SB(1, 1), cB + hstep + kstep, voffB);
        PG8_WAIT_V(6); PG8_BAR;
    } else {
        PG8_STAGE(PG8_SB(0, 0), cB, voffB); PG8_STAGE(PG8_SA(0, 0), cA, voffA); PG8_STAGE(PG8_SB(0, 1), cB + hstep, voffB); PG8_STAGE(PG8_SA(0, 1), cA + hstep, voffA);
        if (wr == 1) PG8_BAR;
        PG8_WAIT_V(4); PG8_BAR;
        PG8_STAGE(PG8_SB(1, 0), cB + kstep, voffB); PG8_STAGE(PG8_SA(1, 0), cA + kstep, voffA); PG8_STAGE(PG8_SB(1, 1), cB + hstep + kstep, voffB);
        PG8_WAIT_V(6); PG8_BAR;
    }
    for (;;) {
        const bool has_next = S.next(ui + 1, nxt);
        const char* nA = has_next ? (const char*)g.A + (size_t)nxt.pm * tstep : cA; const char* nB = has_next ? (const char*)g.Bt + (size_t)nxt.pn * tstep : cB;
        for (int t = 0; t < nt; t += 2) {
            const bool last = (t == nt - 2);
            const char* a1 = cA + (size_t)(t + 1) * kstep;
            const char* a2 = last ? nA : cA + (size_t)(t + 2) * kstep; const char* b2 = last ? nB : cB + (size_t)(t + 2) * kstep;
            const char* a3 = a2 + kstep; const char* b3 = b2 + kstep;
            if (last && has_next) S.a_ready(nxt);
            if constexpr (SP2) {
            PG8_LDB(B0, 0, 0); PG8_LDB(B1, 0, 1); PG8_SCHED; PG8_LDA(At, 0, 0); PG8_STAGE(PG8_SA(1, 1), a1 + hstep, voffA);
            PG8_WAIT_V(8); PG8_WAIT_L(0); PG8_BAR; PG8_MMA(0, 0, At, B0); PG8_MMA(0, 1, At, B1); PG8_BAR; PG8_SCHED;
            PG8_LDA(At, 0, 1); PG8_STAGE(PG8_SB(0, 0), b2, voffB); PG8_STAGE(PG8_SB(0, 1), b2 + hstep, voffB); PG8_STAGE(PG8_SA(0, 0), a2, voffA);
            PG8_WAIT_V(8); PG8_WAIT_L(0); PG8_BAR; PG8_MMA(1, 0, At, B0); PG8_MMA(1, 1, At, B1); PG8_BAR; PG8_SCHED;
            PG8_LDB(B0, 1, 0); PG8_LDB(B1, 1, 1); PG8_SCHED; PG8_LDA(At, 1, 0); PG8_STAGE(PG8_SA(0, 1), a2 + hstep, voffA);
            PG8_WAIT_V(8); PG8_WAIT_L(0); PG8_BAR; PG8_MMA(0, 0, At, B0); PG8_MMA(0, 1, At, B1); PG8_BAR; PG8_SCHED;
            PG8_LDA(At, 1, 1); PG8_STAGE(PG8_SB(1, 0), b3, voffB); PG8_STAGE(PG8_SB(1, 1), b3 + hstep, voffB); PG8_STAGE(PG8_SA(1, 0), a3, voffA);
            PG8_WAIT_V(8); PG8_WAIT_L(0); PG8_BAR; PG8_MMA(1, 0, At, B0); PG8_MMA(1, 1, At, B1); PG8_BAR; PG8_SCHED;
            } else {
            PG8_LDB(B0, 0, 0); PG8_SCHED; PG8_LDA(At, 0, 0); PG8_STAGE(PG8_SA(1, 1), a1 + hstep, voffA);
            PG8_WAIT_L(8); PG8_BAR; PG8_WAIT_L(0); PG8_MMA(0, 0, At, B0); PG8_BAR; PG8_SCHED;
            PG8_LDB(B1, 0, 1); PG8_STAGE(PG8_SB(0, 0), b2, voffB);
            PG8_BAR; PG8_WAIT_L(0); PG8_MMA(0, 1, At, B1); PG8_BAR;
            PG8_LDA(At, 0, 1); PG8_STAGE(PG8_SA(0, 0), a2, voffA);
            PG8_BAR; PG8_WAIT_L(0); PG8_MMA(1, 0, At, B0); PG8_BAR; PG8_SCHED;
            PG8_STAGE(PG8_SB(0, 1), b2 + hstep, voffB);
            PG8_WAIT_V(6); PG8_BAR; PG8_MMA(1, 1, At, B1); PG8_BAR;
            PG8_LDB(B0, 1, 0); PG8_SCHED; PG8_LDA(At, 1, 0); PG8_STAGE(PG8_SA(0, 1), a2 + hstep, voffA);
            PG8_WAIT_L(8); PG8_BAR; PG8_WAIT_L(0); PG8_MMA(0, 0, At, B0); PG8_BAR; PG8_SCHED;
            PG8_LDB(B1, 1, 1); PG8_STAGE(PG8_SB(1, 0), b3, voffB);
            PG8_BAR; PG8_WAIT_L(0); PG8_MMA(0, 1, At, B1); PG8_BAR;
            PG8_LDA(At, 1, 1); PG8_STAGE(PG8_SA(1, 0), a3, voffA);
            PG8_BAR; PG8_WAIT_L(0); PG8_MMA(1, 0, At, B0); PG8_BAR; PG8_SCHED;
            PG8_STAGE(PG8_SB(1, 1), b3 + hstep, voffB);
            PG8_WAIT_V(6); PG8_BAR; PG8_MMA(1, 1, At, B1); PG8_BAR;
            }
        }
        if constexpr (ALIGN_EPI) { if (wr == 0) PG8_BAR; }
        if constexpr (!Epi::AFTER_DRAIN) { E(acc, cur, wr, wc, fr, fq); S.done(cur); }
        if (!has_next) break;
#pragma unroll
        for (int a = 0; a < 2; ++a)
#pragma unroll
            for (int b = 0; b < 2; ++b)
#pragma unroll
                for (int m = 0; m < 4; ++m)
#pragma unroll
                    for (int n = 0; n < 2; ++n) acc[a][b][m][n] = (f32x4){0.f, 0.f, 0.f, 0.f};
        cur = nxt; cA = nA; cB = nB; ++ui;
        if constexpr (ALIGN_EPI) { if (wr == 1) PG8_BAR; }
    }
    PG8_WAIT_V(0);
    if constexpr (!ALIGN_EPI) { if (wr == 0) PG8_BAR; }
    PG8_BAR;
    if constexpr (Epi::AFTER_DRAIN) { E.fused(acc, cur, wr, wc, fr, fq, lds, wid, lane); S.done(cur); }
#undef PG8_SA
#undef PG8_SB
#undef PG8_STAGE
#undef PG8_LDA
#undef PG8_LDB
#undef PG8_MMA
#undef PG8_WAIT_V
#undef PG8_WAIT_L
#undef PG8_BAR
#undef PG8_SCHED
}
}

#define LAS __attribute__((address_space(3)))
#define GASP __attribute__((address_space(1)))
typedef unsigned short bf16;
typedef unsigned U4 __attribute__((ext_vector_type(4)));
typedef unsigned U2 __attribute__((ext_vector_type(2)));
typedef float F4 __attribute__((ext_vector_type(4)));
typedef float F16 __attribute__((ext_vector_type(16)));
typedef short H8 __attribute__((ext_vector_type(8)));
typedef short S4 __attribute__((ext_vector_type(4)));
typedef LAS const unsigned char* lds_cptr;

constexpr int D = 1024, T_P = 65536, T_S = 32768, T = T_P + T_S, FF = 2816, NQKV = 3072;
constexpr int S_P = 4096, S_S = 16384;
constexpr float LOG2E = 1.4426950408889634f;
constexpr float QSCALE = 0.125f * LOG2E;
constexpr float LAMBDA_INIT = 0.35550906759096926f;
constexpr float RMS_EPS = 1e-6f;
constexpr float NEGBIG = -1e30f;

constexpr size_t MiB = 1u << 20;
constexpr size_t WS_WQKV0 = 0, WS_WQKV1 = 6 * MiB, WS_WO0 = 12 * MiB, WS_WO1 = 14 * MiB, WS_WGU0 = 16 * MiB, WS_WGU1 = 27 * MiB, WS_WD0 = 38 * MiB, WS_WD1 = 44 * MiB;
constexpr size_t WS_CTL = 49 * MiB + 960 * 1024, CTL_BYTES = 16384;
constexpr size_t WS_RS = 49 * MiB + 512 * 1024;
static_assert(WS_RS + (size_t)T * 4 <= WS_CTL && WS_WD1 + (size_t)FF * D * 2 <= WS_RS, "rs array");
constexpr size_t WS_XN = 50 * MiB;
constexpr size_t WS_QO = 242 * MiB, WS_K = 434 * MiB, WS_V = 626 * MiB, WS_R = 818 * MiB, WS_END = 1010 * MiB;
constexpr size_t WS_O = WS_XN;
constexpr size_t WS_ACT = WS_QO;
static_assert(WS_ACT + (size_t)T * FF * 2 <= WS_R, "act overlay");
#ifndef REP_NA
#define REP_NA 1
#endif
#ifndef REP_DA
#define REP_DA 1
#endif
#ifndef REP_GEMM
#define REP_GEMM 1
#endif

constexpr int LDS_BYTES = 155648;
constexpr int NWAVES = 8;

__device__ __forceinline__ int crow(int r, int hi) { return (r & 3) + 8 * (r >> 2) + 4 * hi; }
typedef float f32x2_t __attribute__((ext_vector_type(2))); typedef __bf16 bf16x2_t __attribute__((ext_vector_type(2)));
__device__ __forceinline__ unsigned cvtpk(float lo, float hi) { f32x2_t v = {lo, hi}; bf16x2_t b = __builtin_convertvector(v, bf16x2_t); return __builtin_bit_cast(unsigned, b); }
typedef short v4i16_t __attribute__((ext_vector_type(4)));
__device__ __forceinline__ S4 vtr(lds_cptr p) { return __builtin_bit_cast(S4, __builtin_amdgcn_ds_read_tr16_b64_v4i16((LAS v4i16_t*)p)); }
__device__ __forceinline__ float wave_sum(float v) {
#pragma unroll
    for (int o = 1; o < 64; o <<= 1) v += __shfl_xor(v, o);
    return v;
}
__device__ __forceinline__ float half_swap_max(float v) { auto rr = __builtin_amdgcn_permlane32_swap(__float_as_uint(v), __float_as_uint(v), false, false); return fmaxf(__uint_as_float(rr[0]), __uint_as_float(rr[1])); }
__device__ __forceinline__ float half_swap_sum(float v) { auto rr = __builtin_amdgcn_permlane32_swap(__float_as_uint(v), __float_as_uint(v), false, false); return __uint_as_float(rr[0]) + __uint_as_float(rr[1]); }

#define DS_RD128(dst, addr, off) asm volatile("ds_read_b128 %0, %1 offset:%c2" : "=v"(dst) : "v"(addr), "i"(off) : "memory")
#define DS_RDTR(dst, addr, off) asm volatile("ds_read_b64_tr_b16 %0, %1 offset:%c2" : "=v"(dst) : "v"(addr), "i"(off) : "memory")
#define LGKM_WAIT(n) asm volatile("s_waitcnt lgkmcnt(" #n ")" ::: "memory")
#define SCHED_FENCE() __builtin_amdgcn_sched_barrier(0)
template <int NDB>
__device__ __forceinline__ void flash_step(F16& p0, F16& p1, float& m, float& l, F16 (&o)[NDB], LAS float* wsf, lds_cptr vp, int r32, int hi) {
    float a0 = __builtin_fmaxf(__builtin_fmaxf(p0[0], p0[1]), p0[2]), a1 = __builtin_fmaxf(__builtin_fmaxf(p1[0], p1[1]), p1[2]);
#pragma unroll
    for (int r = 3; r < 15; r += 2) { a0 = __builtin_fmaxf(__builtin_fmaxf(a0, p0[r]), p0[r + 1]); a1 = __builtin_fmaxf(__builtin_fmaxf(a1, p1[r]), p1[r + 1]); }
    const float al = __builtin_fmaxf(__builtin_fmaxf(a0, p0[15]), __builtin_fmaxf(a1, p1[15]));
    if (__any(al > m + 8.0f)) {
        const float rm = half_swap_max(al);
        const float mn = fmaxf(m, rm); const float f = __builtin_amdgcn_exp2f(m - mn); l *= f; m = mn;
        if (hi == 0) wsf[r32] = f;
#pragma unroll
        for (int r = 0; r < 16; ++r) { const float fr = wsf[crow(r, hi)];
#pragma unroll
            for (int db = 0; db < NDB; ++db) o[db][r] *= fr; }
    }
    float s = 0.f;
#pragma unroll
    for (int r = 0; r < 16; ++r) { p0[r] = __builtin_amdgcn_exp2f(p0[r] - m); p1[r] = __builtin_amdgcn_exp2f(p1[r] - m); s += p0[r] + p1[r]; }
    l += s;
    U4 pw[4];
#pragma unroll
    for (int k = 0; k < 2; ++k) {
        pw[k]     = (U4){cvtpk(p0[8 * k], p0[8 * k + 1]), cvtpk(p0[8 * k + 2], p0[8 * k + 3]), cvtpk(p0[8 * k + 4], p0[8 * k + 5]), cvtpk(p0[8 * k + 6], p0[8 * k + 7])};
        pw[2 + k] = (U4){cvtpk(p1[8 * k], p1[8 * k + 1]), cvtpk(p1[8 * k + 2], p1[8 * k + 3]), cvtpk(p1[8 * k + 4], p1[8 * k + 5]), cvtpk(p1[8 * k + 6], p1[8 * k + 7])};
    }
    const unsigned vaddr = (unsigned)(uintptr_t)vp;
    S4 va[8];
    static_assert(NDB == 2, "flash_step: two 32-column blocks");
#pragma unroll
    for (int db = 0; db < 2; ++db) {
#pragma unroll
        for (int k = 0; k < 4; ++k) { DS_RDTR(va[2 * k], vaddr, db * 4096 + k * 1024); DS_RDTR(va[2 * k + 1], vaddr, db * 4096 + k * 1024 + 512); }
        LGKM_WAIT(0); SCHED_FENCE();
#pragma unroll
        for (int k = 0; k < 4; ++k) { const H8 vf = (H8){va[2 * k][0], va[2 * k][1], va[2 * k][2], va[2 * k][3], va[2 * k + 1][0], va[2 * k + 1][1], va[2 * k + 1][2], va[2 * k + 1][3]};
            o[db] = __builtin_amdgcn_mfma_f32_32x32x16_bf16(__builtin_bit_cast(H8, pw[k]), vf, o[db], 0, 0, 0); }
        SCHED_FENCE();
    }
}

template <int MODE  , bool NQ>
__device__ __forceinline__ void tr_item(const float* W, int K, int N, bf16* WT, LAS float* scr, int item, int lane, const float* ks, int kmask, float kmul) {
    const int nblk = N / 32, kb = item / nblk, nb = item % nblk, k0 = 64 * kb, n0 = 32 * nb;
    const float nm = (NQ && n0 < 1024) ? QSCALE : 1.f;
#pragma unroll 8
    for (int i = 0; i < 32; ++i) { const int kk = 2 * i + (lane >> 5); float sc = nm; if (ks) sc *= ((const GASP float*)ks)[(k0 + kk) & kmask] * kmul;
        scr[kk * 33 + (lane & 31)] = ((const GASP float*)W)[(size_t)(k0 + kk) * N + n0 + (lane & 31)] * sc; }
    const int c = lane & 7;
#pragma unroll
    for (int j = 0; j < 4; ++j) { const int n = (lane >> 3) + 8 * j; const LAS float* s = scr + (8 * c) * 33 + n;
        U4 o; o.x = cvtpk(s[0 * 33], s[1 * 33]); o.y = cvtpk(s[2 * 33], s[3 * 33]); o.z = cvtpk(s[4 * 33], s[5 * 33]); o.w = cvtpk(s[6 * 33], s[7 * 33]);
        const int nn = n0 + n; const int row = (MODE == 0) ? nn : ((nn >> 7) * 256 + (MODE == 2 ? 128 : 0) + (nn & 127));
        *(GASP U4*)(WT + (size_t)row * K + k0 + 8 * c) = o; }
}

__device__ __forceinline__ void row_to_bf16_rs(const float* xrow, bf16* orow, float* rs, int lane) {
    const GASP F4* xr = (const GASP F4*)xrow + lane;
    F4 v[4]; float s = 0.f;
#pragma unroll
    for (int j = 0; j < 4; ++j) { v[j] = xr[64 * j]; s += (v[j].x * v[j].x + v[j].y * v[j].y) + (v[j].z * v[j].z + v[j].w * v[j].w); }
    const float rstd = rsqrtf(wave_sum(s) * (1.f / D) + RMS_EPS);
    GASP U2* o8 = (GASP U2*)orow + lane;
#pragma unroll
    for (int j = 0; j < 4; ++j) o8[64 * j] = (U2){cvtpk(v[j].x, v[j].y), cvtpk(v[j].z, v[j].w)};
    if (lane == 0) *(GASP float*)rs = rstd;
}

__device__ __forceinline__ F4 bf4(U2 w) { return (F4){__uint_as_float(w.x << 16), __uint_as_float(w.x & 0xffff0000u), __uint_as_float(w.y << 16), __uint_as_float(w.y & 0xffff0000u)}; }
template <bool OUT_F32>
__device__ __forceinline__ void resid_rows2(const bf16* M, bf16* R, float* out, float* RS, const float* g, int m0, int m1, int lane) {
    const int mm[2] = {m0, m1};
    F4 mv[2][4], xv[2][4];
#pragma unroll
    for (int q = 0; q < 2; ++q) { const int m = mm[q]; const GASP U2* mr = (const GASP U2*)(M + (size_t)m * D) + lane; const GASP U2* rr = (const GASP U2*)(R + (size_t)m * D) + lane;
#pragma unroll
        for (int j = 0; j < 4; ++j) { mv[q][j] = bf4(mr[64 * j]); xv[q][j] = bf4(rr[64 * j]); } }
    const GASP F4* gr = (const GASP F4*)g + lane;
#pragma unroll
    for (int q = 0; q < 2; ++q) { const int m = mm[q]; float s = 0.f;
#pragma unroll
        for (int j = 0; j < 4; ++j) s += (mv[q][j].x * mv[q][j].x + mv[q][j].y * mv[q][j].y) + (mv[q][j].z * mv[q][j].z + mv[q][j].w * mv[q][j].w);
        const float rstd = rsqrtf(wave_sum(s) * (1.f / D) + RMS_EPS); float s2 = 0.f;
#pragma unroll
        for (int j = 0; j < 4; ++j) { const F4 gv = gr[64 * j]; xv[q][j] = xv[q][j] + mv[q][j] * rstd * gv; s2 += (xv[q][j].x * xv[q][j].x + xv[q][j].y * xv[q][j].y) + (xv[q][j].z * xv[q][j].z + xv[q][j].w * xv[q][j].w); }
        if (OUT_F32) { GASP F4* orow = (GASP F4*)(out + (size_t)m * D) + lane;
#pragma unroll
            for (int j = 0; j < 4; ++j) orow[64 * j] = xv[q][j]; }
        else { GASP U2* rw = (GASP U2*)(R + (size_t)m * D) + lane;
#pragma unroll
            for (int j = 0; j < 4; ++j) rw[64 * j] = (U2){cvtpk(xv[q][j].x, xv[q][j].y), cvtpk(xv[q][j].z, xv[q][j].w)};
            const float r2 = rsqrtf(wave_sum(s2) * (1.f / D) + RMS_EPS); if (lane == 0) ((GASP float*)RS)[m] = r2; } }
}

__device__ __forceinline__ float na_bfi(int msk, float s) { float r; asm("v_bfi_b32 %0, %1, %2, %3" : "=v"(r) : "v"(msk), "v"(s), "v"(NEGBIG)); return r; }
__device__ __forceinline__ void na_phase(LAS unsigned char* lds, const bf16* Q, const bf16* Kb, const bf16* Vb, bf16* O, const float* rpb, int G, int wave, int lane) {
    const int r32 = lane & 31, hi = lane >> 5;
    LAS unsigned char* vbuf = lds + wave * 16384;
    LAS float* rpbL = (LAS float*)(lds + 131072 + wave * 2048);
    LAS float* wsf = (LAS float*)(lds + 147456 + wave * 128);
    LAS bf16* ost = (LAS bf16*)vbuf;
    const lds_cptr vp = (lds_cptr)vbuf + ((lane >> 4) & 1) * 32 + (lane & 3) * 8 + (4 * hi + ((lane & 15) >> 2)) * 64;
    const int blk = blockIdx.x;
    int x, c, ncx, nX; if (G % 8 == 0) { x = blk % 8; c = blk / 8; ncx = G / 8; nX = 8; } else { x = 0; c = blk; ncx = G; nX = 1; }
    const int per = 3072 / nX;
    int cur_h = -1;
    for (int li = c; li < per; li += ncx) {
        const int U = x * per + li, R = U >> 1, h = 8 * (U & 1) + wave;
        if (h != cur_h) { for (int i = lane; i < 465; i += 64) rpbL[i] = ((const GASP float*)rpb)[h * 465 + i] * LOG2E; cur_h = h; }
        int r, nrows; if (R < 1024) { r = R & 63; nrows = 64; } else { r = (R - 1024) & 255; nrows = 256; }
        const int Rbase = R - r; const int row0 = min(max(r - 4, 0), nrows - 8);
        {
            H8 qfa[4], qfb[4];
#pragma unroll
            for (int d0 = 0; d0 < 4; ++d0) { qfa[d0] = *(const GASP H8*)(Q + ((size_t)h * T + (size_t)R * 64 + r32) * 64 + 16 * d0 + 8 * hi); qfb[d0] = *(const GASP H8*)(Q + ((size_t)h * T + (size_t)R * 64 + 32 + r32) * 64 + 16 * d0 + 8 * hi); }
            unsigned nmask[2];
#pragma unroll
            for (int qb = 0; qb < 2; ++qb) { const int qc_ = 32 * qb + r32, qs_ = min(max(qc_ - 8, 0), 48), uu = 4 * hi - qs_; unsigned w_ = 0u;
#pragma unroll
                for (int rr = 0; rr < 16; ++rr) { const int kcst = (rr & 3) + 8 * (rr >> 2); w_ |= ((unsigned)(uu + kcst) < 16u ? 1u : 0u) << rr; w_ |= ((unsigned)(uu + kcst + 32) < 16u ? 1u : 0u) << (16 + rr); }
                nmask[qb] = w_; }
            float ma = NEGBIG, mb = NEGBIG, la = 0.f, lb = 0.f; F16 oa[2], ob[2]; oa[0] = F16{}; oa[1] = F16{}; ob[0] = F16{}; ob[1] = F16{};
            H8 kn[8];
            const char* kub = (const char*)Kb + ((size_t)h * T + (size_t)(Rbase + row0) * 64) * 128;
            const char* vub = (const char*)Vb + ((size_t)h * T + (size_t)(Rbase + row0) * 64) * 128;
            const unsigned kofs = (unsigned)((r32 * 64 + 8 * hi) * 2);
            const unsigned vofs = (unsigned)(((lane >> 2) * 64 + (lane & 3) * 8) * 2);
#define NA_KLOAD() do { _Pragma("unroll") for (int d0 = 0; d0 < 4; ++d0) { kn[2 * d0] = *(const GASP H8*)(kub + kofs + 32 * d0); kn[2 * d0 + 1] = *(const GASP H8*)(kub + kofs + 32 * 128 + 32 * d0); } } while (0)
#define NA_VDMA(buf) do { _Pragma("unroll") for (int i_ = 0; i_ < 8; ++i_) \
        __builtin_amdgcn_global_load_lds((const unsigned*)(vub + vofs + (16 * (i_ & 3)) * 128 + (i_ >> 2) * 64), (LAS unsigned*)(vbuf + (buf) * 8192 + i_ * 1024), 16, 0, 0); } while (0)
#define NA_SCORES(QF, QB, P0, P1) do { P0 = F16{}; P1 = F16{}; \
        _Pragma("unroll") for (int d0 = 0; d0 < 4; ++d0) { P0 = __builtin_amdgcn_mfma_f32_32x32x16_bf16(kn[2 * d0], QF[d0], P0, 0, 0, 0); P1 = __builtin_amdgcn_mfma_f32_32x32x16_bf16(kn[2 * d0 + 1], QF[d0], P1, 0, 0, 0); } \
        const int qc_ = 32 * (QB) + r32; \
        int uu2 = 4 * hi - qc_ + 15; unsigned mw_ = nmask[QB]; asm volatile("" : "+v"(uu2), "+v"(mw_));     \
        const LAS float* brow = rpbL + dr * 31 + uu2; \
        _Pragma("unroll") for (int g4 = 0; g4 < 4; ++g4) { float b0_[4], b1_[4]; \
            _Pragma("unroll") for (int e = 0; e < 4; ++e) { b0_[e] = brow[8 * g4 + e]; b1_[e] = brow[8 * g4 + e + 32]; } \
            _Pragma("unroll") for (int e = 0; e < 4; ++e) asm volatile("" : "+v"(b0_[e]), "+v"(b1_[e]));     \
            _Pragma("unroll") for (int e = 0; e < 4; ++e) { const int rr = 4 * g4 + e, kcst = 8 * g4 + e; \
                (void)kcst; const int k0_ = __builtin_amdgcn_sbfe((int)mw_, rr, 1), k1_ = __builtin_amdgcn_sbfe((int)mw_, 16 + rr, 1);     \
                const float s0 = P0[rr] + b0_[e], s1 = P1[rr] + b1_[e]; \
                P0[rr] = na_bfi(k0_, s0); P1[rr] = na_bfi(k1_, s1); } } } while (0)
#define NA_STORE(OO, LL, QB) do { int le_ = lane; asm volatile("" : "+v"(le_)); const int r32e = le_ & 31, hie = le_ >> 5;     \
        const float lt = half_swap_sum(LL); if (hie == 0) wsf[r32e] = 1.0f / lt; \
        _Pragma("unroll") for (int rr = 0; rr < 16; ++rr) { const float f = wsf[crow(rr, hie)]; const int orow = crow(rr, hie); \
            _Pragma("unroll") for (int db = 0; db < 2; ++db) { const unsigned w = cvtpk(OO[db][rr] * f, 0.f); ost[orow * 64 + db * 32 + r32e] = (bf16)(w & 0xffffu); } } \
        _Pragma("unroll") for (int i = 0; i < 4; ++i) { const int row = i * 8 + (le_ >> 3), ch = le_ & 7; const U4 v = *(const LAS U4*)(ost + row * 64 + ch * 8); \
            *(GASP U4*)(O + ((size_t)R * 64 + 32 * (QB) + row) * D + h * 64 + ch * 8) = v; } } while (0)
            NA_VDMA(0);
            NA_KLOAD();
#pragma unroll 1
            for (int kr = 0; kr < 8; ++kr) {
                asm volatile("s_waitcnt vmcnt(0)" ::: "memory");
                const int dr = row0 + kr - r + 7;
                {   F16 p0, p1; NA_SCORES(qfa, 0, p0, p1);
                    flash_step<2>(p0, p1, ma, la, oa, wsf, vp + (kr & 1) * 8192, r32, hi); }
                {   F16 p0, p1; NA_SCORES(qfb, 1, p0, p1);
                    if (kr < 7) { kub += 64 * 128; vub += 64 * 128;
                        if (kr & 1) NA_VDMA(0); else NA_VDMA(1);
                        NA_KLOAD(); }
                    flash_step<2>(p0, p1, mb, lb, ob, wsf, vp + (kr & 1) * 8192, r32, hi); }
            }
            NA_STORE(oa, la, 0);
            NA_STORE(ob, lb, 1);
#undef NA_VDMA
#undef NA_KLOAD
#undef NA_SCORES
#undef NA_STORE
        }
    }
}

__device__ __forceinline__ int t5_bucket(int rel) { const int n = rel < 0 ? -rel : rel; const int big = min(15, 2 + (31 - __clz(n * n | 1))); return (rel > 0 ? 16 : 0) + (n < 8 ? n : big); }
typedef float F2 __attribute__((ext_vector_type(2)));
#define DA_VREADS(v, vaddr, DB) do { _Pragma("unroll") for (int k_ = 0; k_ < 4; ++k_) { DS_RDTR(v[2 * k_], vaddr, (DB) * 4096 + k_ * 1024); DS_RDTR(v[2 * k_ + 1], vaddr, (DB) * 4096 + k_ * 1024 + 512); } } while (0)
#define DA_VMFMA(v, DB) do { _Pragma("unroll") for (int k_ = 0; k_ < 4; ++k_) { const H8 vf_ = (H8){v[2 * k_][0], v[2 * k_][1], v[2 * k_][2], v[2 * k_][3], v[2 * k_ + 1][0], v[2 * k_ + 1][1], v[2 * k_ + 1][2], v[2 * k_ + 1][3]}; \
        o[DB] = __builtin_amdgcn_mfma_f32_32x32x16_bf16(__builtin_bit_cast(H8, pw[k_]), vf_, o[DB], 0, 0, 0); } } while (0)
__device__ __forceinline__ void da_pv(F16 (&o)[4], const U4 (&pw)[4], S4 (&va)[8], S4 (&vb)[8], unsigned vaddr) {
    LGKM_WAIT(0); SCHED_FENCE(); DA_VMFMA(va, 0); SCHED_FENCE();
    DA_VREADS(va, vaddr, 2); SCHED_FENCE(); DA_VMFMA(vb, 1); SCHED_FENCE();
    DA_VREADS(vb, vaddr, 3); LGKM_WAIT(8); SCHED_FENCE(); DA_VMFMA(va, 2); SCHED_FENCE();
    LGKM_WAIT(0); SCHED_FENCE(); DA_VMFMA(vb, 3); SCHED_FENCE();
}
#define DA_ILV() do { _Pragma("unroll") for (int g_ = 0; g_ < 4; ++g_) { __builtin_amdgcn_sched_group_barrier(0x008, 1, 0); __builtin_amdgcn_sched_group_barrier(0x002, 4, 0); } } while (0)
#define DA_EXP8(P, B, acc) do { _Pragma("unroll") for (int r_ = 0; r_ < 8; ++r_) { P[(B) + r_] = __builtin_amdgcn_exp2f(P[(B) + r_]); acc += P[(B) + r_]; } } while (0)
__device__ __forceinline__ float fadd_s(float a, float b) { float r; asm("v_add_f32_e32 %0, %1, %2" : "=v"(r) : "v"(a), "v"(b)); return r; }
#define DA_GAP(v, DB, K_, P, B, acc) do { const H8 vf_ = (H8){v[2 * (K_)][0], v[2 * (K_)][1], v[2 * (K_)][2], v[2 * (K_)][3], v[2 * (K_) + 1][0], v[2 * (K_) + 1][1], v[2 * (K_) + 1][2], v[2 * (K_) + 1][3]}; \
        o[DB] = __builtin_amdgcn_mfma_f32_32x32x16_bf16(__builtin_bit_cast(H8, pw[K_]), vf_, o[DB], 0, 0, 0); \
        P[(B)] = __builtin_amdgcn_exp2f(P[(B)]); P[(B) + 1] = __builtin_amdgcn_exp2f(P[(B) + 1]); acc += P[(B)]; acc += P[(B) + 1]; SCHED_FENCE(); } while (0)
#define DA_GROUP(v, DB, P, B, acc) do { DA_GAP(v, DB, 0, P, (B), acc); DA_GAP(v, DB, 1, P, (B) + 2, acc); DA_GAP(v, DB, 2, P, (B) + 4, acc); DA_GAP(v, DB, 3, P, (B) + 6, acc); } while (0)
#define DA_PACK8(P, B) (U4){cvtpk(P[(B)], P[(B) + 1]), cvtpk(P[(B) + 2], P[(B) + 3]), cvtpk(P[(B) + 4], P[(B) + 5]), cvtpk(P[(B) + 6], P[(B) + 7])}
__device__ __forceinline__ void da_phase(LAS unsigned char* lds, const bf16* Q, const bf16* Kb, const bf16* Vb, bf16* O, const float* lq1, const float* lk1, const float* lq2, const float* lk2,
                                         const float* t5, int G, int wave, int lane, int tid) {
    const int r32 = lane & 31, hi = lane >> 5, comp = wave >> 2, w4 = wave & 3;
    constexpr int KS = 0, VS = 49152;
    LAS bf16* ost = (LAS bf16*)(lds + 114688 + w4 * 8192);
    LAS float* lut = (LAS float*)(lds + 147456);
    LAS float* wsf = (LAS float*)(lds + 149504 + wave * 128);
    const float lam = __builtin_expf(wave_sum(lq1[lane] * lk1[lane])) - __builtin_expf(wave_sum(lq2[lane] * lk2[lane])) + LAMBDA_INIT;
    const int blk = blockIdx.x;
    int x, c, ncx, nX; if (G % 8 == 0) { x = blk % 8; c = blk / 8; ncx = G / 8; nX = 8; } else { x = 0; c = blk; ncx = G; nX = 1; }
    const int perP = 4096 / nX, perS = 2048 / nX, per = perP + perS;
    const int vlane = ((lane >> 4) & 1) * 32 + (lane & 3) * 8 + (4 * hi + ((lane & 15) >> 2)) * 64;
    const unsigned ldsb = (unsigned)(uintptr_t)lds;
    int cur_h = -1;
    for (int li = c; li < per; li += ncx) {
        int b, h, qb, S; size_t tok0;
        if (li < perP) { const int gi = x * perP + li; const int pair = gi >> 5; qb = gi & 31; b = pair >> 3; h = pair & 7; S = S_P; tok0 = (size_t)b * S_P; }
        else { const int gi = x * perS + (li - perP); const int pair = gi >> 7; qb = gi & 127; b = pair >> 3; h = pair & 7; S = S_S; tok0 = (size_t)T_P + (size_t)b * S_S; }
        if (h != cur_h) { __syncthreads(); for (int i = tid; i < 257; i += 512) lut[i] = ((const GASP float*)t5)[t5_bucket(i - 128) * 8 + h] * LOG2E; __syncthreads(); cur_h = h; }
        const int qrow0 = qb * 128 + 32 * w4;
        H8 qf[4];
#pragma unroll
        for (int d0 = 0; d0 < 4; ++d0) qf[d0] = *(const GASP H8*)(Q + ((size_t)h * T + tok0 + qrow0 + r32) * 128 + comp * 64 + 16 * d0 + 8 * hi);
        float m = 0.f, l = 0.f; F16 o[4];
#pragma unroll
        for (int db = 0; db < 4; ++db) o[db] = F16{};
        int cur_cls = -1; float cb = 0.f, cbm = 0.f;
        U4 pw[4] = {};
        const int NT = S / 64;
        const char* kub = (const char*)Kb + (((size_t)h * T + tok0 + 32 * (wave & 1)) * 128 + (wave >> 2) * 64 + ((wave >> 1) & 1) * 32) * 2;
        const char* vub = (const char*)Vb + (((size_t)h * T + tok0 + 16 * ((2 * wave) & 3)) * 128 + ((2 * wave) >> 2) * 32) * 2;
        const unsigned kofs = (unsigned)(((lane >> 2) * 128 + ((lane & 3) ^ ((lane >> 4) & 3)) * 8) * 2);
        const unsigned vofs = (unsigned)(((lane >> 2) * 128 + (lane & 3) * 8) * 2);
#define DA_DMA_K(tt, kslot) do { const char* kb_ = kub + (size_t)(tt) * (64 * 128 * 2); \
        __builtin_amdgcn_global_load_lds((const unsigned*)(kb_ + kofs), (LAS unsigned*)(lds + KS + (kslot) * 16384 + (2 * wave) * 1024), 16, 0, 0); \
        __builtin_amdgcn_global_load_lds((const unsigned*)(kb_ + 16 * 128 * 2 + kofs), (LAS unsigned*)(lds + KS + (kslot) * 16384 + (2 * wave + 1) * 1024), 16, 0, 0); } while (0)
#define DA_DMA_V(tt, vslot) do { const char* vb_ = vub + (size_t)(tt) * (64 * 128 * 2); \
        __builtin_amdgcn_global_load_lds((const unsigned*)(vb_ + vofs), (LAS unsigned*)(lds + VS + (vslot) * 16384 + (2 * wave) * 1024), 16, 0, 0); \
        __builtin_amdgcn_global_load_lds((const unsigned*)(vb_ + 16 * 128 * 2 + vofs), (LAS unsigned*)(lds + VS + (vslot) * 16384 + (2 * wave + 1) * 1024), 16, 0, 0); } while (0)
#define DA_DMA(tt, kslot, vslot) do { DA_DMA_K(tt, kslot); DA_DMA_V(tt, vslot); } while (0)
        DA_DMA(0, 0, 0); DA_DMA(1, 1, 1);
        int ks_cur = 0, ks_n2 = 2;
        const unsigned kswz = (unsigned)((hi ^ ((r32 >> 2) & 3)) * 16);
        const unsigned ka_base = ldsb + KS + comp * 8192 + r32 * 64;
        S4 va[8], vb[8];
#pragma unroll 1
        for (int t = 0; t < NT; ++t) {
            if (t + 1 < NT) asm volatile("s_waitcnt vmcnt(4)" ::: "memory"); else asm volatile("s_waitcnt vmcnt(0)" ::: "memory");
            __builtin_amdgcn_s_barrier();
            asm volatile("" ::: "memory");
            const unsigned vaddr_p = ldsb + VS + ((t == 0 ? 0 : t + 3) & 3) * 16384 + vlane;
            U4 kf[4];
            const unsigned ka0 = ka_base + ks_cur * 16384 + kswz, ka1 = ka_base + ks_cur * 16384 + (kswz ^ 32u);
            DS_RD128(kf[0], ka0, 0); DS_RD128(kf[1], ka1, 0); DS_RD128(kf[2], ka0, 4096); DS_RD128(kf[3], ka1, 4096);
            DA_VREADS(va, vaddr_p, 0); DA_VREADS(vb, vaddr_p, 1);
            const int kv0 = 64 * t; const int relmin = kv0 - (qrow0 + 31), relmax = kv0 + 63 - qrow0;
            const int cls = (relmin >= 128) ? 2 : ((relmax <= -128) ? 0 : 1);
            if (cls != cur_cls) { cur_cls = cls; cb = (cls == 2) ? lut[256] : ((cls == 0) ? lut[0] : 0.f); cbm = cb - m; }
            F16 p0, p1;
            {   typedef float F2i __attribute__((ext_vector_type(2))); F2i c2 = {cbm, cbm}; asm volatile("" : "+v"(c2));
#pragma unroll
                for (int r = 0; r < 16; r += 2) { p0[r] = c2.x; p0[r + 1] = c2.y; p1[r] = c2.x; p1[r + 1] = c2.y; } }
            asm volatile("s_waitcnt lgkmcnt(15)" ::: "memory"); SCHED_FENCE();
#pragma unroll
            for (int d0 = 0; d0 < 4; ++d0) p0 = __builtin_amdgcn_mfma_f32_32x32x16_bf16(__builtin_bit_cast(H8, kf[d0]), qf[d0], p0, 0, 0, 0);
            SCHED_FENCE();
            DS_RD128(kf[0], ka0, 2048); DS_RD128(kf[1], ka1, 2048); DS_RD128(kf[2], ka0, 6144); DS_RD128(kf[3], ka1, 6144);
            if (t + 2 < NT) DA_DMA_K(t + 2, ks_n2);
            LGKM_WAIT(0); SCHED_FENCE();
            float a0;
            p1 = __builtin_amdgcn_mfma_f32_32x32x16_bf16(__builtin_bit_cast(H8, kf[0]), qf[0], p1, 0, 0, 0); a0 = __builtin_fmaxf(__builtin_fmaxf(p0[0], p0[1]), p0[2]); a0 = __builtin_fmaxf(__builtin_fmaxf(a0, p0[3]), p0[4]); asm volatile("" : "+v"(a0)); SCHED_FENCE();
            p1 = __builtin_amdgcn_mfma_f32_32x32x16_bf16(__builtin_bit_cast(H8, kf[1]), qf[1], p1, 0, 0, 0); a0 = __builtin_fmaxf(__builtin_fmaxf(a0, p0[5]), p0[6]); a0 = __builtin_fmaxf(__builtin_fmaxf(a0, p0[7]), p0[8]); asm volatile("" : "+v"(a0)); SCHED_FENCE();
            p1 = __builtin_amdgcn_mfma_f32_32x32x16_bf16(__builtin_bit_cast(H8, kf[2]), qf[2], p1, 0, 0, 0); a0 = __builtin_fmaxf(__builtin_fmaxf(a0, p0[9]), p0[10]); a0 = __builtin_fmaxf(__builtin_fmaxf(a0, p0[11]), p0[12]); asm volatile("" : "+v"(a0)); SCHED_FENCE();
            p1 = __builtin_amdgcn_mfma_f32_32x32x16_bf16(__builtin_bit_cast(H8, kf[3]), qf[3], p1, 0, 0, 0); a0 = __builtin_fmaxf(__builtin_fmaxf(a0, p0[13]), p0[14]); a0 = __builtin_fmaxf(a0, p0[15]); asm volatile("" : "+v"(a0)); SCHED_FENCE();
            if (t + 2 < NT) DA_DMA_V(t + 2, (t + 2) & 3);
            if (cls == 1) { const int base = kv0 - (qrow0 + r32) + 128;
#pragma unroll
                for (int r = 0; r < 16; ++r) { const int i0 = base + crow(r, hi), i1 = i0 + 32;
                    p0[r] += lut[min(max(i0, 0), 256)]; p1[r] += lut[min(max(i1, 0), 256)];
                    if ((r & 1) == 1) asm volatile("" ::: "memory"); }
                a0 = __builtin_fmaxf(__builtin_fmaxf(p0[0], p0[1]), p0[2]);
#pragma unroll
                for (int r = 3; r < 15; r += 2) a0 = __builtin_fmaxf(__builtin_fmaxf(a0, p0[r]), p0[r + 1]);
                a0 = __builtin_fmaxf(a0, p0[15]); }
            float a1 = __builtin_fmaxf(__builtin_fmaxf(p1[0], p1[1]), p1[2]);
#pragma unroll
            for (int r = 3; r < 15; r += 2) a1 = __builtin_fmaxf(__builtin_fmaxf(a1, p1[r]), p1[r + 1]);
            a1 = __builtin_fmaxf(a1, p1[15]);
            const float rml = __builtin_fmaxf(a0, a1);
            if (t == 0 || __any(rml > 8.0f)) {
                const float rm = half_swap_max(rml);
                const float dl = (t == 0) ? rm : __builtin_fmaxf(rm, 0.f); m += dl;
#pragma unroll
                for (int r = 0; r < 16; ++r) { p0[r] -= dl; p1[r] -= dl; }
                cbm = cb - m;
                const float f = __builtin_amdgcn_exp2f(-dl); l *= f;
#pragma unroll
                for (int k = 0; k < 4; ++k)
#pragma unroll
                    for (int e = 0; e < 4; ++e) { const unsigned w = pw[k][e]; pw[k][e] = cvtpk(__uint_as_float(w << 16) * f, __uint_as_float(w & 0xffff0000u) * f); }
                if (hi == 0) wsf[r32] = f;
#pragma unroll
                for (int r = 0; r < 16; ++r) { const float fr = wsf[crow(r, hi)];
#pragma unroll
                    for (int db = 0; db < 4; ++db) o[db][r] *= fr; }
            }
            float sa = 0.f, sb = 0.f;
            SCHED_FENCE(); DA_GROUP(va, 0, p0, 0, sa);
            DA_VREADS(va, vaddr_p, 2); SCHED_FENCE();
            DA_GROUP(vb, 1, p0, 8, sa);
            DA_VREADS(vb, vaddr_p, 3); LGKM_WAIT(8); SCHED_FENCE();
            DA_GROUP(va, 2, p1, 0, sa);
            LGKM_WAIT(0); SCHED_FENCE();
            DA_GROUP(vb, 3, p1, 8, sa);
            l += sa + sb;
            pw[0] = DA_PACK8(p0, 0); pw[1] = DA_PACK8(p0, 8); pw[2] = DA_PACK8(p1, 0); pw[3] = DA_PACK8(p1, 8);
            ks_cur = (ks_cur == 2) ? 0 : ks_cur + 1; ks_n2 = (ks_n2 == 2) ? 0 : ks_n2 + 1;
        }
        {   const unsigned vaddr = ldsb + VS + ((NT - 1) & 3) * 16384 + vlane; DA_VREADS(va, vaddr, 0); DA_VREADS(vb, vaddr, 1); da_pv(o, pw, va, vb, vaddr); }
#undef DA_DMA
#undef DA_DMA_K
#undef DA_DMA_V
        int lane_e = lane; asm volatile("" : "+v"(lane_e));
        const int r32e = lane_e & 31, hie = lane_e >> 5;
        const float lt = half_swap_sum(l);
        if (hie == 0) wsf[r32e] = (comp == 0 ? 1.0f : -lam) / lt;
#pragma unroll
        for (int r = 0; r < 16; ++r) { const float f = wsf[crow(r, hie)];
#pragma unroll
            for (int db = 0; db < 4; ++db) o[db][r] *= f; }
        __syncthreads();
        LAS float* xb = (LAS float*)lds + w4 * 4096;
        if (comp == 1) {
#pragma unroll
            for (int db = 0; db < 4; ++db)
#pragma unroll
                for (int r = 0; r < 16; ++r) xb[(db * 16 + r) * 64 + lane_e] = o[db][r];
        }
        __syncthreads();
        if (comp == 0) {
            float ss[16];
#pragma unroll
            for (int r = 0; r < 16; ++r) { float q = 0.f;
#pragma unroll
                for (int db = 0; db < 4; ++db) { o[db][r] += xb[(db * 16 + r) * 64 + lane_e]; q += o[db][r] * o[db][r]; }
                ss[r] = q; }
#pragma unroll
            for (int r = 0; r < 16; ++r) {
#pragma unroll
                for (int off = 1; off < 32; off <<= 1) ss[r] += __shfl_xor(ss[r], off);
                const float rs = rsqrtf(ss[r] * (1.0f / 128.0f) + RMS_EPS); const int orow = crow(r, hie);
#pragma unroll
                for (int db = 0; db < 4; ++db) { const unsigned w = cvtpk(o[db][r] * rs, 0.f); ost[orow * 128 + db * 32 + r32e] = (bf16)(w & 0xffffu); } }
#pragma unroll
            for (int i = 0; i < 8; ++i) { const int row = i * 4 + (lane_e >> 4), ch = lane_e & 15; const U4 v = *(const LAS U4*)(ost + row * 128 + ch * 8);
                *(GASP U4*)(O + (tok0 + qrow0 + row) * D + h * 128 + ch * 8) = v; }
        }
        __syncthreads();
    }
}

#define XB_TMO      128
#define XB_XCNT(j)  (256  + 64 * (j))
#define XB_XSUB(j)  (1280 + 64 * (j))
#define XB_XGEN(j)  (2304 + 64 * (j))
#define XB_TOP      3328
#define XB_TOPGEN   3392
#define XCD_BAR_WORDS 3456
#define XB_SPIN_CAP (1u << 18)

__device__ __forceinline__ unsigned xb_ld(unsigned* p)              { return __hip_atomic_load(p, __ATOMIC_RELAXED, __HIP_MEMORY_SCOPE_AGENT); }
__device__ __forceinline__ unsigned xb_add(unsigned* p, unsigned v) { return __hip_atomic_fetch_add(p, v, __ATOMIC_RELAXED, __HIP_MEMORY_SCOPE_AGENT); }
__device__ __forceinline__ unsigned xb_xcc_id() { return (unsigned)__builtin_amdgcn_s_getreg((3 << 11) | 20) & 0xFu; }
#define XB_SPIN(cond, bar) do { unsigned _sp = 0; while (cond) { __builtin_amdgcn_s_sleep(1); \
    if ((++_sp & 255u) == 0u) { if (xb_ld(&(bar)[XB_TMO])) break; if (_sp > XB_SPIN_CAP) { atomicAdd(&(bar)[XB_TMO], 1u); break; } } } } while (0)

struct XcdBarrier {
    unsigned* bar; unsigned x;
    volatile LAS unsigned* st;
};

__device__ __forceinline__ XcdBarrier xcd_barrier_post(unsigned* bar, volatile LAS unsigned* st, int xb_tid) {
    XcdBarrier b; b.bar = bar; b.x = xb_xcc_id(); b.st = st;
    if (xb_tid == 0) (void)xb_add(&bar[XB_XCNT(b.x)], 1u);
    return b;
}
__device__ __forceinline__ void xcd_barrier_complete(unsigned* bar, unsigned x, unsigned& nloc, unsigned& nx) {
    const unsigned G = gridDim.x * gridDim.y * gridDim.z;
    unsigned sum, cnt, mine, sp = 0u;
    for (;;) {
        sum = 0u; cnt = 0u; mine = 0u;
#pragma unroll
        for (unsigned j = 0; j < 16; ++j) { const unsigned c = xb_ld(&bar[XB_XCNT(j)]); sum += c; cnt += (c > 0u) ? 1u : 0u; mine = (j == x) ? c : mine; }
        if (sum == G) break;
        __builtin_amdgcn_s_sleep(1);
        if ((++sp & 255u) == 0u) { if (xb_ld(&bar[XB_TMO])) break; if (sp > XB_SPIN_CAP) { atomicAdd(&bar[XB_TMO], 1u); break; } }
    }
    nloc = mine > 0u ? mine : 1u; nx = cnt > 0u ? cnt : 1u;
}

__device__ __forceinline__ void xcd_barrier(const XcdBarrier& b, int xb_tid) {
    asm volatile("s_waitcnt vmcnt(0)" ::: "memory");
    __syncthreads();
    if (xb_tid == 0) {
        unsigned* bar = b.bar;
        __builtin_amdgcn_s_waitcnt(0);
        unsigned nloc = b.st[0], nx = b.st[1];
        if (nloc == 0u) { xcd_barrier_complete(bar, b.x, nloc, nx); b.st[0] = nloc; b.st[1] = nx; }
        const unsigned old = xb_add(&bar[XB_XSUB(b.x)], 1u);
        const unsigned gen = old / nloc;
        if (old + 1u == (gen + 1u) * nloc) {
            __builtin_amdgcn_fence(__ATOMIC_RELEASE, "agent");
            asm volatile("s_waitcnt vmcnt(0)" ::: "memory");
            const unsigned og = xb_add(&bar[XB_TOP], 1u);
            const unsigned tg = og / nx;
            if (og + 1u == (tg + 1u) * nx) xb_add(&bar[XB_TOPGEN], 1u);
            else XB_SPIN(xb_ld(&bar[XB_TOPGEN]) == tg, bar);
            __builtin_amdgcn_fence(__ATOMIC_ACQUIRE, "agent");
            xb_add(&bar[XB_XGEN(b.x)], 1u);
            asm volatile("s_waitcnt vmcnt(0)" ::: "memory");
        } else {
            XB_SPIN(xb_ld(&bar[XB_XGEN(b.x)]) == gen, bar);
            __builtin_amdgcn_fence(__ATOMIC_ACQUIRE, "agent");
            asm volatile("s_waitcnt vmcnt(0)" ::: "memory");
        }
    }
    __syncthreads();
}

#define GAS __attribute__((address_space(1)))
template <class Tp> __device__ __forceinline__ Tp* gptr(Tp* p) { return (Tp*)(GAS Tp*)p; }
struct Args { const float* in[20]; float* out; unsigned char* ws; };
__global__ void __launch_bounds__(NWAVES * 64, 2) mega_fwd(Args a) {
    extern __shared__ __attribute__((aligned(16))) unsigned char lds_raw[];
    LAS unsigned char* lds = (LAS unsigned char*)lds_raw;
    cg::grid_group grid = cg::this_grid();
    const int G = gridDim.x;
    const int wave0 = __builtin_amdgcn_readfirstlane((int)threadIdx.x >> 6);
    volatile LAS unsigned* xb_st = (volatile LAS unsigned*)(lds + LDS_BYTES - 16);
    if (threadIdx.x == 0) { xb_st[0] = 0u; xb_st[1] = 0u; }
    __syncthreads();
    (void)xcd_barrier_post((unsigned*)(gptr(a.ws) + WS_CTL), xb_st, (int)threadIdx.x);
#define GRID_SYNC() do { XcdBarrier xb_; unsigned char* wsb_ = a.ws; asm volatile("" : "+s"(wsb_)); xb_.bar = (unsigned*)(gptr(wsb_) + WS_CTL); xb_.x = xb_xcc_id(); xb_.st = (volatile LAS unsigned*)(lds + LDS_BYTES - 16); \
        unsigned on_ = ~0u; asm volatile("" : "+s"(on_)); xcd_barrier(xb_, wave0 * 64 + (int)__builtin_amdgcn_mbcnt_hi(on_, __builtin_amdgcn_mbcnt_lo(on_, 0u))); } while (0)
#define PHASE_IDS() unsigned ones_ = ~0u; asm volatile("" : "+s"(ones_)); int tid = wave0 * 64 + (int)__builtin_amdgcn_mbcnt_hi(ones_, __builtin_amdgcn_mbcnt_lo(ones_, 0u)); asm volatile("" : "+v"(tid)); const int lane = tid & 63, wave = wave0; \
    const int gw = blockIdx.x * NWAVES + wave, NGW = G * NWAVES; (void)gw; (void)NGW; (void)lane; \
    unsigned char* ws0_ = a.ws; asm volatile("" : "+s"(ws0_)); unsigned char* ws = gptr(ws0_); \
    bf16* XN = (bf16*)(ws + WS_XN); bf16* QO = (bf16*)(ws + WS_QO); bf16* KB = (bf16*)(ws + WS_K); bf16* VB = (bf16*)(ws + WS_V); bf16* ACT = (bf16*)(ws + WS_ACT); bf16* OB = (bf16*)(ws + WS_O); bf16* RB = (bf16*)(ws + WS_R); float* RS = (float*)(ws + WS_RS); (void)OB; (void)RB; (void)RS; \
    (void)XN; (void)QO; (void)KB; (void)VB; (void)ACT

#ifndef REP_PRO
#define REP_PRO 1
#endif
#ifndef REP_NORM
#define REP_NORM 1
#endif
#ifndef EXTRA_SYNC
#define EXTRA_SYNC 0
#endif
#pragma unroll 1
    for (int rep = 0; rep < REP_PRO; ++rep)
    {
        PHASE_IDS();
        const float* xp = gptr(a.in[0]); const float* xs = gptr(a.in[1]);
        LAS float* scr = (LAS float*)(lds + wave * 16384);
        constexpr int I_QKV = 16 * 96, I_O = 16 * 32, I_G = 16 * 88, I_D = 44 * 32, I_L = I_QKV + I_O + 2 * I_G + I_D;
#pragma unroll 1
        for (int it = gw; it < 2 * I_L; it += NGW) {
            const int L = it / I_L; int r = it % I_L;
            if (r < I_QKV) { tr_item<0, true>(L == 0 ? gptr(a.in[4]) : gptr(a.in[7]), D, NQKV, (bf16*)(ws + (L == 0 ? WS_WQKV0 : WS_WQKV1)), scr, r, lane, gptr(a.in[2]) + L * D, 1023, 1.f); continue; } r -= I_QKV;
            if (r < I_O) { tr_item<0, false>(L == 0 ? gptr(a.in[5]) : gptr(a.in[8]), D, D, (bf16*)(ws + (L == 0 ? WS_WO0 : WS_WO1)), scr, r, lane, L == 0 ? nullptr : gptr(a.in[13]), 127, 1.0f - LAMBDA_INIT); continue; } r -= I_O;
            if (r < I_G) { tr_item<1, false>(gptr(a.in[17]) + (size_t)L * D * FF, D, FF, (bf16*)(ws + (L == 0 ? WS_WGU0 : WS_WGU1)), scr, r, lane, gptr(a.in[15]) + L * D, 1023, 1.f); continue; } r -= I_G;
            if (r < I_G) { tr_item<2, false>(gptr(a.in[18]) + (size_t)L * D * FF, D, FF, (bf16*)(ws + (L == 0 ? WS_WGU0 : WS_WGU1)), scr, r, lane, gptr(a.in[15]) + L * D, 1023, 1.f); continue; } r -= I_G;
            tr_item<0, false>(gptr(a.in[19]) + (size_t)L * FF * D, FF, D, (bf16*)(ws + (L == 0 ? WS_WD0 : WS_WD1)), scr, r, lane, nullptr, 0, 1.f);
        }
#pragma unroll 1
        for (int m = gw; m < T; m += NGW) row_to_bf16_rs(m < T_P ? xp + (size_t)m * D : xs + (size_t)(m - T_P) * D, RB + (size_t)m * D, RS + m, lane);
    }
    grid.sync();
#pragma unroll 1
    for (int rep = 0; rep < EXTRA_SYNC; ++rep) GRID_SYNC();

#pragma unroll 1
    for (int L = 0; L < 2; ++L) {
#pragma unroll 1
        for (int rep = 0; rep < REP_GEMM; ++rep) {
        {   PHASE_IDS(); const bf16* Wqkv = (const bf16*)(ws + (L == 0 ? WS_WQKV0 : WS_WQKV1));
            pg8::Gemm g{RB, Wqkv, T, NQKV, D}; pg8::StaticOrder S; S.init(T, NQKV, G, (int)blockIdx.x);
            pg8::EpiQKV E{QO, (size_t)(WS_K - WS_QO) / 2, L == 0 ? 6 : 7, T, RS};
            pg8::gemm_phase<pg8::EpiQKV, pg8::StaticOrder, true, true>(lds, g, S, E, tid); }
        GRID_SYNC(); }
        if (L == 0) {
#pragma unroll 1
            for (int rep = 0; rep < REP_NA; ++rep) { { PHASE_IDS(); na_phase(lds, QO, KB, VB, OB, gptr(a.in[6]), G, wave, lane); } GRID_SYNC(); }
        } else {
#pragma unroll 1
            for (int rep = 0; rep < REP_DA; ++rep) { { PHASE_IDS(); da_phase(lds, QO, KB, VB, OB, gptr(a.in[9]), gptr(a.in[10]), gptr(a.in[11]), gptr(a.in[12]), gptr(a.in[14]), G, wave, lane, tid); } GRID_SYNC(); }
        }
#pragma unroll 1
        for (int rep = 0; rep < REP_GEMM; ++rep) {
        {   PHASE_IDS(); const bf16* Wo = (const bf16*)(ws + (L == 0 ? WS_WO0 : WS_WO1));
            pg8::Gemm g{OB, Wo, T, D, D}; pg8::StaticOrder S; S.init(T, D, G, (int)blockIdx.x);
            pg8::EpiBf16<0> E{KB, D, nullptr, 0, 0, 1.f};
            pg8::gemm_phase<pg8::EpiBf16<0>, pg8::StaticOrder, true, true>(lds, g, S, E, tid); }
        GRID_SYNC(); }
        {   PHASE_IDS(); const float* gp = gptr(a.in[3]) + L * D;
#pragma unroll 1
            for (int rep = 0; rep < REP_NORM; ++rep)
#pragma unroll 1
                for (int m = gw; m < T; m += 2 * NGW) resid_rows2<false>(KB, RB, nullptr, RS, gp, m, (m + NGW < T) ? m + NGW : m, lane);
        }
        GRID_SYNC();
#pragma unroll 1
        for (int rep = 0; rep < REP_GEMM; ++rep) {
        {   PHASE_IDS(); const bf16* Wgu = (const bf16*)(ws + (L == 0 ? WS_WGU0 : WS_WGU1));
            pg8::Gemm g{RB, Wgu, T, 2 * FF, D}; pg8::StaticOrder S; S.init(T, 2 * FF, G, (int)blockIdx.x);
            pg8::EpiSwiglu E{ACT, FF, RS};
            pg8::gemm_phase<pg8::EpiSwiglu, pg8::StaticOrder, true, true>(lds, g, S, E, tid); }
        GRID_SYNC(); }
#pragma unroll 1
        for (int rep = 0; rep < REP_GEMM; ++rep) {
        {   PHASE_IDS(); const bf16* Wd = (const bf16*)(ws + (L == 0 ? WS_WD0 : WS_WD1));
            pg8::Gemm g{ACT, Wd, T, D, FF}; pg8::StaticOrder S; S.init(T, D, G, (int)blockIdx.x);
            pg8::EpiBf16<0> E{XN, D, nullptr, 0, 0, 1.f};
            pg8::gemm_phase<pg8::EpiBf16<0>, pg8::StaticOrder, true, true>(lds, g, S, E, tid); }
        GRID_SYNC(); }
        {   PHASE_IDS(); float* out = gptr(a.out); const float* gp = gptr(a.in[16]) + L * D;
            if (L == 0) {
#pragma unroll 1
                for (int m = gw; m < T; m += 2 * NGW) resid_rows2<false>(XN, RB, nullptr, RS, gp, m, (m + NGW < T) ? m + NGW : m, lane);
            } else {
#pragma unroll 1
                for (int m = gw; m < T; m += 2 * NGW) resid_rows2<true>(XN, RB, out, RS, gp, m, (m + NGW < T) ? m + NGW : m, lane);
            } }
        if (L == 0) GRID_SYNC();
    }
}

extern "C" void kernel_launch(void* const* d_in, const int* in_sizes, int n_in, void* d_out, int out_size, void* d_ws, size_t ws_size, hipStream_t stream) {
    static int grid = 0;
    if (grid == 0) {
        if (n_in != 20 || out_size != T * D || ws_size < WS_END) { fprintf(stderr, "kernel_launch: unexpected problem (n_in %d, out %d, ws %zu)\n", n_in, out_size, ws_size); grid = -1; return; }
        int dev = 0, cus = 0, per_cu = 0;
        if (hipGetDevice(&dev) != hipSuccess || hipDeviceGetAttribute(&cus, hipDeviceAttributeMultiprocessorCount, dev) != hipSuccess) { grid = -1; return; }
        if (hipFuncSetAttribute((const void*)mega_fwd, hipFuncAttributeMaxDynamicSharedMemorySize, LDS_BYTES) != hipSuccess) { fprintf(stderr, "kernel_launch: hipFuncSetAttribute failed\n"); grid = -1; return; }
        if (hipOccupancyMaxActiveBlocksPerMultiprocessor(&per_cu, (const void*)mega_fwd, NWAVES * 64, LDS_BYTES) != hipSuccess || per_cu < 1) { fprintf(stderr, "kernel_launch: occupancy query says %d\n", per_cu); (void)hipGetLastError(); per_cu = 1; }
        grid = cus * per_cu;
    }
    if (grid < 0) return;
    Args a{};
    for (int i = 0; i < 20; ++i) a.in[i] = (const float*)d_in[i];
    a.out = (float*)d_out; a.ws = (unsigned char*)d_ws;
    if (hipMemsetAsync((char*)d_ws + WS_CTL, 0, CTL_BYTES, stream) != hipSuccess) { fprintf(stderr, "kernel_launch: hipMemsetAsync failed\n"); return; }
    void* args[] = {&a};
    hipError_t e = hipLaunchCooperativeKernel((const void*)mega_fwd, dim3(grid), dim3(NWAVES * 64), args, LDS_BYTES, stream);
    if (e != hipSuccess) fprintf(stderr, "kernel_launch: cooperative launch failed: %s (grid %d)\n", hipGetErrorString(e), grid);
}
```

```cpp
#include <hip/hip_runtime.h>
#include <hip/hip_cooperative_groups.h>
#include <hip/hip_bf16.h>
#include <cstdio>
#include <cstdint>
namespace cg = cooperative_groups;
namespace pg8 {
#define PG8_LAS __attribute__((address_space(3)))
typedef unsigned short bf16_t;
typedef short bf16x8 __attribute__((ext_vector_type(8)));
typedef float f32x4 __attribute__((ext_vector_type(4)));
typedef unsigned u32x4 __attribute__((ext_vector_type(4)));
constexpr int BM = 256, BK = 64, HALF = 128, HTB = HALF * BK * 2  , STAGE_BYTES = 8 * HTB, NXCD = 8, WGM = 8;

__host__ __device__ __forceinline__ int lds_byte(int r, int c) { const int st = (r >> 4) * 2 + (c >> 5), rr = r & 15, cc = c & 31, ob = rr * 64 + cc * 2; return st * 1024 + (ob ^ (((ob >> 9) & 1) << 5)); }
__host__ __device__ __forceinline__ void stage_rc(int b, int& R, int& C) { const int st = b / 1024, sb = b % 1024, swz = sb ^ (((sb >> 9) & 1) << 5); R = (st >> 1) * 16 + swz / 64; C = (st & 1) * 32 + (swz % 64) / 2; }
__host__ __device__ __forceinline__ int perm32(int rho) { const int n = rho >> 4, i = rho & 15; return 8 * (i >> 2) + 4 * n + (i & 3); }

struct Unit { int pm, pn; };
struct Gemm { const bf16_t* A; const bf16_t* Bt; int M, N, K; };

struct StaticOrder {
    int nM, nN, nwg, G, c;
    __host__ __device__ void init(int M, int N, int G_, int c_) { nM = M / BM; nN = N / BM; nwg = nM * nN; G = G_; c = c_; }
    __host__ __device__ bool next(int i, Unit& u) const {
        const long L = (long)i * G + c; if (L >= nwg) return false;
        int wgid = (int)L; { const int q = nwg / NXCD, r = nwg % NXCD, xcd = wgid % NXCD, off = wgid / NXCD; wgid = (xcd < r ? xcd * (q + 1) : r * (q + 1) + (xcd - r) * q) + off; }
        const int nig = WGM * nN, gid = wgid / nig, fm = gid * WGM, gsz = (nM - fm) < WGM ? (nM - fm) : WGM;
        u.pm = fm + ((wgid % nig) % gsz); u.pn = (wgid % nig) / gsz; return true;
    }
    __device__ __forceinline__ void a_ready(const Unit&) const {}
    __device__ __forceinline__ void done(const Unit&) const {}
};

__device__ __forceinline__ unsigned cvt_pk_bf16(float lo, float hi) { unsigned r; asm volatile("v_cvt_pk_bf16_f32 %0, %1, %2" : "=v"(r) : "v"(lo), "v"(hi)); return r; }
typedef float f32x2 __attribute__((ext_vector_type(2)));
__device__ __forceinline__ f32x2 gelu_pk(f32x2 v) {
    const f32x2 av = __builtin_elementwise_abs(v), d = av * 0.2316418882f + 1.0f;
    f32x2 t; t.x = __builtin_amdgcn_rcpf(d.x); t.y = __builtin_amdgcn_rcpf(d.y);
    f32x2 q = t * 0.5307027145f + (-0.7265760135f); q = q * t + 0.7107068705f; q = q * t + (-0.142248368f); q = q * t + 0.127414796f; q = q * t;
    const f32x2 s = (v * v) * (-0.72134752044f);
    f32x2 e; e.x = __builtin_amdgcn_exp2f(s.x); e.y = __builtin_amdgcn_exp2f(s.y);
    const f32x2 m = v * (q * e), r = v - m;
    f32x2 o; o.x = v.x < 0.f ? m.x : r.x; o.y = v.y < 0.f ? m.y : r.y; return o;
}

template <int ACT  > struct EpiBf16 {
    static constexpr bool PERM = true, AFTER_DRAIN = false; static_assert(ACT == 0 || ACT == 1, "EpiBf16: ACT is 0 (none) or 1 (gelu_pk)");
    bf16_t* O; int ldc; const float* bias; int split_cols; size_t split_stride; float scale0;
    __device__ __forceinline__ void operator()(const f32x4 (&acc)[2][2][4][2], const Unit& u, int wr, int wc, int fr, int fq) const {
        const int row0 = u.pm * BM + wr * 64 + fr; int colt = u.pn * BM; bf16_t* base = O;
        float sc = 1.f; if (split_cols) { const int t = colt / split_cols; base += (size_t)t * split_stride; colt -= t * split_cols; if (t == 0) sc = scale0; }
        const int col0 = colt + wc * 32 + 8 * fq, bcol0 = u.pn * BM + wc * 32 + 8 * fq;
        f32x4 bv[2][2];
#pragma unroll
        for (int bj = 0; bj < 2; ++bj)
#pragma unroll
            for (int n = 0; n < 2; ++n) bv[bj][n] = bias ? *(const f32x4*)(bias + bcol0 + bj * HALF + 4 * n) : (f32x4){0.f, 0.f, 0.f, 0.f};
#pragma unroll
        for (int ai = 0; ai < 2; ++ai)
#pragma unroll
            for (int m = 0; m < 4; ++m) { bf16_t* rowp = base + (size_t)(row0 + ai * HALF + m * 16) * ldc + col0;
#pragma unroll
                for (int bj = 0; bj < 2; ++bj) { f32x4 v0 = acc[ai][bj][m][0] + bv[bj][0], v1 = acc[ai][bj][m][1] + bv[bj][1];
                    if (ACT == 1) { f32x2 a = gelu_pk((f32x2){v0[0], v0[1]}), b = gelu_pk((f32x2){v0[2], v0[3]}), c = gelu_pk((f32x2){v1[0], v1[1]}), d = gelu_pk((f32x2){v1[2], v1[3]});
                        v0 = (f32x4){a.x, a.y, b.x, b.y}; v1 = (f32x4){c.x, c.y, d.x, d.y}; }
                    v0 = v0 * sc; v1 = v1 * sc; u32x4 w; w.x = cvt_pk_bf16(v0[0], v0[1]); w.y = cvt_pk_bf16(v0[2], v0[3]); w.z = cvt_pk_bf16(v1[0], v1[1]); w.w = cvt_pk_bf16(v1[2], v1[3]);
                    *(__attribute__((address_space(1))) u32x4*)(rowp + bj * HALF) = w; } }
    }
};
struct EpiSwiglu {
    static constexpr bool PERM = true, AFTER_DRAIN = false;
    bf16_t* O; int ldc; const float* rs;
    __device__ __forceinline__ void operator()(const f32x4 (&acc)[2][2][4][2], const Unit& u, int wr, int wc, int fr, int fq) const {
        const int row0 = u.pm * BM + wr * 64 + fr; const int col0 = u.pn * HALF + wc * 32 + 8 * fq;
        float scv[2][4];
#pragma unroll
        for (int ai = 0; ai < 2; ++ai)
#pragma unroll
            for (int m = 0; m < 4; ++m) scv[ai][m] = ((const __attribute__((address_space(1))) float*)rs)[row0 + ai * HALF + m * 16];
#pragma unroll
        for (int ai = 0; ai < 2; ++ai)
#pragma unroll
            for (int m = 0; m < 4; ++m) { bf16_t* rowp = O + (size_t)(row0 + ai * HALF + m * 16) * ldc + col0; const float sc = scv[ai][m], kx = -1.4426950408889634f * sc, sc2 = sc * sc;
                float v[8];
#pragma unroll
                for (int n = 0; n < 2; ++n)
#pragma unroll
                    for (int e = 0; e < 4; ++e) { const float ga = acc[ai][0][m][n][e], ua = acc[ai][1][m][n][e];
                        const float s = __builtin_amdgcn_rcpf(1.0f + __builtin_amdgcn_exp2f(kx * ga)); v[n * 4 + e] = (ga * ua) * (s * sc2); }
                u32x4 w; w.x = cvt_pk_bf16(v[0], v[1]); w.y = cvt_pk_bf16(v[2], v[3]); w.z = cvt_pk_bf16(v[4], v[5]); w.w = cvt_pk_bf16(v[6], v[7]);
                *(__attribute__((address_space(1))) u32x4*)rowp = w; }
    }
};
struct EpiQKV {
    static constexpr bool PERM = true, AFTER_DRAIN = false;
    bf16_t* O; size_t tstride; int hw_log2; int M; const float* rs;
    __device__ __forceinline__ void operator()(const f32x4 (&acc)[2][2][4][2], const Unit& u, int wr, int wc, int fr, int fq) const {
        const int row0 = u.pm * BM + wr * 64 + fr; const int colt = u.pn * BM; const int t = colt >> 10;
        bf16_t* base = O + (size_t)t * tstride; const int hw = 1 << hw_log2;
        float scv[2][4];
#pragma unroll
        for (int ai = 0; ai < 2; ++ai)
#pragma unroll
            for (int m = 0; m < 4; ++m) scv[ai][m] = ((const __attribute__((address_space(1))) float*)rs)[row0 + ai * HALF + m * 16];
#pragma unroll
        for (int bj = 0; bj < 2; ++bj) { const int col = (colt & 1023) + bj * HALF + wc * 32 + 8 * fq; const int head = col >> hw_log2, within = col & (hw - 1);
            bf16_t* hp = base + ((size_t)head * M << hw_log2) + within;
#pragma unroll
            for (int ai = 0; ai < 2; ++ai)
#pragma unroll
                for (int m = 0; m < 4; ++m) { const float sc = scv[ai][m]; const f32x4 v0 = acc[ai][bj][m][0] * sc, v1 = acc[ai][bj][m][1] * sc;
                    u32x4 w; w.x = cvt_pk_bf16(v0[0], v0[1]); w.y = cvt_pk_bf16(v0[2], v0[3]); w.z = cvt_pk_bf16(v1[0], v1[1]); w.w = cvt_pk_bf16(v1[2], v1[3]);
                    *(__attribute__((address_space(1))) u32x4*)(hp + ((size_t)(row0 + ai * HALF + m * 16) << hw_log2)) = w; } }
    }
};
template <class Epi, class Sched, bool ALIGN_EPI = false, bool SP2 = false>
__device__ __forceinline__ void gemm_phase(PG8_LAS unsigned char* lds, const Gemm g, const Sched& S, const Epi& E, int tid_in) {
    int tid_l = tid_in; asm volatile("" : "+v"(tid_l));
    const int tid = tid_l, wid = __builtin_amdgcn_readfirstlane(tid >> 6), lane = tid & 63, wr = wid >> 2, wc = wid & 3, fr = lane & 15, fq = lane >> 4;
    const int K = g.K, nt = K / BK;
    unsigned voffA[2], voffB[2];
#pragma unroll
    for (int i = 0; i < 2; ++i) { int R, C; stage_rc(tid * 16 + i * 8192, R, C); const int Rb = Epi::PERM ? ((R & ~31) + perm32(R & 31)) : R;
        voffA[i] = (unsigned)(R * K + C) * 2u; voffB[i] = (unsigned)(Rb * K + C) * 2u; }
    const size_t kstep = (size_t)(BK * 2);
    const size_t hstep = (size_t)HALF * K * 2;
    const size_t tstep = 2 * hstep;
    const unsigned ldsw = (unsigned)wid * 1024u;
    const int aoff = lds_byte(wr * 64 + fr, fq * 8), boff = lds_byte(wc * 32 + fr, fq * 8);
#define PG8_SA(b, h) (((b) * 2 + (h)) * HTB)
#define PG8_SB(b, h) ((4 + (b) * 2 + (h)) * HTB)
#define PG8_STAGE(bufoff, gbase, voff) do { _Pragma("unroll") for (int _i = 0; _i < 2; ++_i) \
        __builtin_amdgcn_global_load_lds((const unsigned*)((const char*)(gbase) + (voff)[_i]), (PG8_LAS unsigned*)(lds + (bufoff) + ldsw + _i * 8192), 16, 0, 0); } while (0)
#define PG8_LDA(dst, b, h) do { _Pragma("unroll") for (int m = 0; m < 4; ++m) _Pragma("unroll") for (int k = 0; k < 2; ++k) dst[m][k] = *(const PG8_LAS bf16x8*)(lds + PG8_SA(b, h) + aoff + m * 2048 + k * 1024); } while (0)
#define PG8_LDB(dst, b, h) do { _Pragma("unroll") for (int n = 0; n < 2; ++n) _Pragma("unroll") for (int k = 0; k < 2; ++k) dst[n][k] = *(const PG8_LAS bf16x8*)(lds + PG8_SB(b, h) + boff + n * 2048 + k * 1024); } while (0)
#define PG8_MMA(ai, bj, At, Bt) do { __builtin_amdgcn_s_setprio(1); _Pragma("unroll") for (int m = 0; m < 4; ++m) _Pragma("unroll") for (int n = 0; n < 2; ++n) _Pragma("unroll") for (int k = 0; k < 2; ++k) \
        acc[ai][bj][m][n] = __builtin_amdgcn_mfma_f32_16x16x32_bf16(Bt[n][k], At[m][k], acc[ai][bj][m][n], 0, 0, 0); __builtin_amdgcn_s_setprio(0); } while (0)
#define PG8_WAIT_V(n) asm volatile("s_waitcnt vmcnt(" #n ")" ::: "memory")
#define PG8_WAIT_L(n) asm volatile("s_waitcnt lgkmcnt(" #n ")" ::: "memory")
#define PG8_BAR __builtin_amdgcn_s_barrier()
#define PG8_SCHED __builtin_amdgcn_sched_barrier(0)
    Unit cur, nxt; int ui = 0;
    if (!S.next(0, cur)) return;
    f32x4 acc[2][2][4][2];
#pragma unroll
    for (int a = 0; a < 2; ++a)
#pragma unroll
        for (int b = 0; b < 2; ++b)
#pragma unroll
            for (int m = 0; m < 4; ++m)
#pragma unroll
                for (int n = 0; n < 2; ++n) acc[a][b][m][n] = (f32x4){0.f, 0.f, 0.f, 0.f};
    bf16x8 At[4][2], B0[2][2], B1[2][2];
    const char* cA = (const char*)g.A + (size_t)cur.pm * tstep; const char* cB = (const char*)g.Bt + (size_t)cur.pn * tstep;
    S.a_ready(cur);
    if constexpr (SP2) {
        PG8_STAGE(PG8_SB(0, 0), cB, voffB); PG8_STAGE(PG8_SB(0, 1), cB + hstep, voffB); PG8_STAGE(PG8_SA(0, 0), cA, voffA); PG8_STAGE(PG8_SA(0, 1), cA + hstep, voffA);
        if (wr == 1) PG8_BAR;
        PG8_WAIT_V(2); PG8_BAR;
        PG8_STAGE(PG8_SB(1, 0), cB + kstep, voffB); PG8_STAGE(PG8_SA(1, 0), cA + kstep, voffA); PG8_STAGE(PG8_SB(1, 1), cB + hstep + kstep, voffB);
        PG8_WAIT_V(6); PG8_BAR;
    } else {
        PG8_STAGE(PG8_SB(0, 0), cB, voffB); PG8_STAGE(PG8_SA(0, 0), cA, voffA); PG8_STAGE(PG8_SB(0, 1), cB + hstep, voffB); PG8_STAGE(PG8_SA(0, 1), cA + hstep, voffA);
        if (wr == 1) PG8_BAR;
        PG8_WAIT_V(4); PG8_BAR;
        PG8_STAGE(PG8_SB(1, 0), cB + kstep, voffB); PG8_STAGE(PG8_SA(1, 0), cA + kstep, voffA); PG8_STAGE(PG8_SB(1, 1), cB + hstep + kstep, voffB);
        PG8_WAIT_V(6); PG8_BAR;
    }
    for (;;) {
        const bool has_next = S.next(ui + 1, nxt);
        const char* nA = has_next ? (const char*)g.A + (size_t)nxt.pm * tstep : cA; const char* nB = has_next ? (const char*)g.Bt + (size_t)nxt.pn * tstep : cB;
        for (int t = 0; t < nt; t += 2) {
            const bool last = (t == nt - 2);
            const char* a1 = cA + (size_t)(t + 1) * kstep;
            const char* a2 = last ? nA : cA + (size_t)(t + 2) * kstep; const char* b2 = last ? nB : cB + (size_t)(t + 2) * kstep;
            const char* a3 = a2 + kstep; const char* b3 = b2 + kstep;
            if (last && has_next) S.a_ready(nxt);
            if constexpr (SP2) {
            PG8_LDB(B0, 0, 0); PG8_LDB(B1, 0, 1); PG8_SCHED; PG8_LDA(At, 0, 0); PG8_STAGE(PG8_SA(1, 1), a1 + hstep, voffA);
            PG8_WAIT_V(8); PG8_WAIT_L(0); PG8_BAR; PG8_MMA(0, 0, At, B0); PG8_MMA(0, 1, At, B1); PG8_BAR; PG8_SCHED;
            PG8_LDA(At, 0, 1); PG8_STAGE(PG8_SB(0, 0), b2, voffB); PG8_STAGE(PG8_SB(0, 1), b2 + hstep, voffB); PG8_STAGE(PG8_SA(0, 0), a2, voffA);
            PG8_WAIT_V(8); PG8_WAIT_L(0); PG8_BAR; PG8_MMA(1, 0, At, B0); PG8_MMA(1, 1, At, B1); PG8_BAR; PG8_SCHED;
            PG8_LDB(B0, 1, 0); PG8_LDB(B1, 1, 1); PG8_SCHED; PG8_LDA(At, 1, 0); PG8_STAGE(PG8_SA(0, 1), a2 + hstep, voffA);
            PG8_WAIT_V(8); PG8_WAIT_L(0); PG8_BAR; PG8_MMA(0, 0, At, B0); PG8_MMA(0, 1, At, B1); PG8_BAR; PG8_SCHED;
            PG8_LDA(At, 1, 1); PG8_STAGE(PG8_SB(1, 0), b3, voffB); PG8_STAGE(PG8_SB(1, 1), b3 + hstep, voffB); PG8_STAGE(PG8_SA(1, 0), a3, voffA);
            PG8_WAIT_V(8); PG8_WAIT_L(0); PG8_BAR; PG8_MMA(1, 0, At, B0); PG8_MMA(1, 1, At, B1); PG8_BAR; PG8_SCHED;
            } else {
            PG8_LDB(B0, 0, 0); PG8_SCHED; PG8_LDA(At, 0, 0); PG8_STAGE(PG8_SA(1, 1), a1 + hstep, voffA);
            PG8_WAIT_L(8); PG8_BAR; PG8_WAIT_L(0); PG8_MMA(0, 0, At, B0); PG8_BAR; PG8_SCHED;
            PG8_LDB(B1, 0, 1); PG8_STAGE(PG8_SB(0, 0), b2, voffB);
            PG8_BAR; PG8_WAIT_L(0); PG8_MMA(0, 1, At, B1); PG8_BAR;
            PG8_LDA(At, 0, 1); PG8_STAGE(PG8_SA(0, 0), a2, voffA);
            PG8_BAR; PG8_WAIT_L(0); PG8_MMA(1, 0, At, B0); PG8_BAR; PG8_SCHED;
            PG8_STAGE(PG8_SB(0, 1), b2 + hstep, voffB);
            PG8_WAIT_V(6); PG8_BAR; PG8_MMA(1, 1, At, B1); PG8_BAR;
            PG8_LDB(B0, 1, 0); PG8_SCHED; PG8_LDA(At, 1, 0); PG8_STAGE(PG8_SA(0, 1), a2 + hstep, voffA);
            PG8_WAIT_L(8); PG8_BAR; PG8_WAIT_L(0); PG8_MMA(0, 0, At, B0); PG8_BAR; PG8_SCHED;
            PG8_LDB(B1, 1, 1); PG8_STAGE(PG8_SB(1, 0), b3, voffB);
            PG8_BAR; PG8_WAIT_L(0); PG8_MMA(0, 1, At, B1); PG8_BAR;
            PG8_LDA(At, 1, 1); PG8_STAGE(PG8_SA(1, 0), a3, voffA);
            PG8_BAR; PG8_WAIT_L(0); PG8_MMA(1, 0, At, B0); PG8_BAR; PG8_SCHED;
            PG8_STAGE(PG8_SB(1, 1), b3 + hstep, voffB);
            PG8_WAIT_V(6); PG8_BAR; PG8_MMA(1, 1, At, B1); PG8_BAR;
            }
        }
        if constexpr (ALIGN_EPI) { if (wr == 0) PG8_BAR; }
        if constexpr (!Epi::AFTER_DRAIN) { E(acc, cur, wr, wc, fr, fq); S.done(cur); }
        if (!has_next) break;
#pragma unroll
        for (int a = 0; a < 2; ++a)
#pragma unroll
            for (int b = 0; b < 2; ++b)
#pragma unroll
                for (int m = 0; m < 4; ++m)
#pragma unroll
                    for (int n = 0; n < 2; ++n) acc[a][b][m][n] = (f32x4){0.f, 0.f, 0.f, 0.f};
        cur = nxt; cA = nA; cB = nB; ++ui;
        if constexpr (ALIGN_EPI) { if (wr == 1) PG8_BAR; }
    }
    PG8_WAIT_V(0);
    if constexpr (!ALIGN_EPI) { if (wr == 0) PG8_BAR; }
    PG8_BAR;
    if constexpr (Epi::AFTER_DRAIN) { E.fused(acc, cur, wr, wc, fr, fq, lds, wid, lane); S.done(cur); }
#undef PG8_SA
#undef PG8_SB
#undef PG8_STAGE
#undef PG8_LDA
#undef PG8_LDB
#undef PG8_MMA
#undef PG8_WAIT_V
#undef PG8_WAIT_L
#undef PG8_BAR
#undef PG8_SCHED
}
}

#define LAS __attribute__((address_space(3)))
#define GASP __attribute__((address_space(1)))
typedef unsigned short bf16;
typedef unsigned U4 __attribute__((ext_vector_type(4)));
typedef unsigned U2 __attribute__((ext_vector_type(2)));
typedef float F4 __attribute__((ext_vector_type(4)));
typedef float F16 __attribute__((ext_vector_type(16)));
typedef short H8 __attribute__((ext_vector_type(8)));
typedef short S4 __attribute__((ext_vector_type(4)));
typedef LAS const unsigned char* lds_cptr;

constexpr int D = 1024, T_P = 65536, T_S = 32768, T = T_P + T_S, FF = 2816, NQKV = 3072;
constexpr int S_P = 4096, S_S = 16384;
constexpr float LOG2E = 1.4426950408889634f;
constexpr float QSCALE = 0.125f * LOG2E;
constexpr float LAMBDA_INIT = 0.35550906759096926f;
constexpr float RMS_EPS = 1e-6f;
constexpr float NEGBIG = -1e30f;

constexpr size_t MiB = 1u << 20;
constexpr size_t WS_WQKV0 = 0, WS_WQKV1 = 6 * MiB, WS_WO0 = 12 * MiB, WS_WO1 = 14 * MiB, WS_WGU0 = 16 * MiB, WS_WGU1 = 27 * MiB, WS_WD0 = 38 * MiB, WS_WD1 = 44 * MiB;
constexpr size_t WS_CTL = 49 * MiB + 960 * 1024, CTL_BYTES = 16384;
constexpr size_t WS_RS = 49 * MiB + 512 * 1024;
static_assert(WS_RS + (size_t)T * 4 <= WS_CTL && WS_WD1 + (size_t)FF * D * 2 <= WS_RS, "rs array");
constexpr size_t WS_XN = 50 * MiB;
constexpr size_t WS_QO = 242 * MiB, WS_K = 434 * MiB, WS_V = 626 * MiB, WS_R = 818 * MiB, WS_END = 1010 * MiB;
constexpr size_t WS_O = WS_XN;
constexpr size_t WS_ACT = WS_QO;
static_assert(WS_ACT + (size_t)T * FF * 2 <= WS_R, "act overlay");
#ifndef REP_NA
#define REP_NA 1
#endif
#ifndef REP_DA
#define REP_DA 1
#endif
#ifndef REP_GEMM
#define REP_GEMM 1
#endif

constexpr int LDS_BYTES = 155648;
constexpr int NWAVES = 8;

__device__ __forceinline__ int crow(int r, int hi) { return (r & 3) + 8 * (r >> 2) + 4 * hi; }
typedef float f32x2_t __attribute__((ext_vector_type(2))); typedef __bf16 bf16x2_t __attribute__((ext_vector_type(2)));
__device__ __forceinline__ unsigned cvtpk(float lo, float hi) { f32x2_t v = {lo, hi}; bf16x2_t b = __builtin_convertvector(v, bf16x2_t); return __builtin_bit_cast(unsigned, b); }
typedef short v4i16_t __attribute__((ext_vector_type(4)));
__device__ __forceinline__ S4 vtr(lds_cptr p) { return __builtin_bit_cast(S4, __builtin_amdgcn_ds_read_tr16_b64_v4i16((LAS v4i16_t*)p)); }
__device__ __forceinline__ float wave_sum(float v) {
#pragma unroll
    for (int o = 1; o < 64; o <<= 1) v += __shfl_xor(v, o);
    return v;
}
__device__ __forceinline__ float half_swap_max(float v) { auto rr = __builtin_amdgcn_permlane32_swap(__float_as_uint(v), __float_as_uint(v), false, false); return fmaxf(__uint_as_float(rr[0]), __uint_as_float(rr[1])); }
__device__ __forceinline__ float half_swap_sum(float v) { auto rr = __builtin_amdgcn_permlane32_swap(__float_as_uint(v), __float_as_uint(v), false, false); return __uint_as_float(rr[0]) + __uint_as_float(rr[1]); }

#define DS_RD128(dst, addr, off) asm volatile("ds_read_b128 %0, %1 offset:%c2" : "=v"(dst) : "v"(addr), "i"(off) : "memory")
#define DS_RDTR(dst, addr, off) asm volatile("ds_read_b64_tr_b16 %0, %1 offset:%c2" : "=v"(dst) : "v"(addr), "i"(off) : "memory")
#define LGKM_WAIT(n) asm volatile("s_waitcnt lgkmcnt(" #n ")" ::: "memory")
#define SCHED_FENCE() __builtin_amdgcn_sched_barrier(0)
template <int NDB>
__device__ __forceinline__ void flash_step(F16& p0, F16& p1, float& m, float& l, F16 (&o)[NDB], LAS float* wsf, lds_cptr vp, int r32, int hi) {
    float a0 = __builtin_fmaxf(__builtin_fmaxf(p0[0], p0[1]), p0[2]), a1 = __builtin_fmaxf(__builtin_fmaxf(p1[0], p1[1]), p1[2]);
#pragma unroll
    for (int r = 3; r < 15; r += 2) { a0 = __builtin_fmaxf(__builtin_fmaxf(a0, p0[r]), p0[r + 1]); a1 = __builtin_fmaxf(__builtin_fmaxf(a1, p1[r]), p1[r + 1]); }
    const float al = __builtin_fmaxf(__builtin_fmaxf(a0, p0[15]), __builtin_fmaxf(a1, p1[15]));
    if (__any(al > m + 8.0f)) {
        const float rm = half_swap_max(al);
        const float mn = fmaxf(m, rm); const float f = __builtin_amdgcn_exp2f(m - mn); l *= f; m = mn;
        if (hi == 0) wsf[r32] = f;
#pragma unroll
        for (int r = 0; r < 16; ++r) { const float fr = wsf[crow(r, hi)];
#pragma unroll
            for (int db = 0; db < NDB; ++db) o[db][r] *= fr; }
    }
    float s = 0.f;
#pragma unroll
    for (int r = 0; r < 16; ++r) { p0[r] = __builtin_amdgcn_exp2f(p0[r] - m); p1[r] = __builtin_amdgcn_exp2f(p1[r] - m); s += p0[r] + p1[r]; }
    l += s;
    U4 pw[4];
#pragma unroll
    for (int k = 0; k < 2; ++k) {
        pw[k]     = (U4){cvtpk(p0[8 * k], p0[8 * k + 1]), cvtpk(p0[8 * k + 2], p0[8 * k + 3]), cvtpk(p0[8 * k + 4], p0[8 * k + 5]), cvtpk(p0[8 * k + 6], p0[8 * k + 7])};
        pw[2 + k] = (U4){cvtpk(p1[8 * k], p1[8 * k + 1]), cvtpk(p1[8 * k + 2], p1[8 * k + 3]), cvtpk(p1[8 * k + 4], p1[8 * k + 5]), cvtpk(p1[8 * k + 6], p1[8 * k + 7])};
    }
    const unsigned vaddr = (unsigned)(uintptr_t)vp;
    S4 va[8];
    static_assert(NDB == 2, "flash_step: two 32-column blocks");
#pragma unroll
    for (int db = 0; db < 2; ++db) {
#pragma unroll
        for (int k = 0; k < 4; ++k) { DS_RDTR(va[2 * k], vaddr, db * 4096 + k * 1024); DS_RDTR(va[2 * k + 1], vaddr, db * 4096 + k * 1024 + 512); }
        LGKM_WAIT(0); SCHED_FENCE();
#pragma unroll
        for (int k = 0; k < 4; ++k) { const H8 vf = (H8){va[2 * k][0], va[2 * k][1], va[2 * k][2], va[2 * k][3], va[2 * k + 1][0], va[2 * k + 1][1], va[2 * k + 1][2], va[2 * k + 1][3]};
            o[db] = __builtin_amdgcn_mfma_f32_32x32x16_bf16(__builtin_bit_cast(H8, pw[k]), vf, o[db], 0, 0, 0); }
        SCHED_FENCE();
    }
}

template <int MODE  , bool NQ>
__device__ __forceinline__ void tr_item(const float* W, int K, int N, bf16* WT, LAS float* scr, int item, int lane, const float* ks, int kmask, float kmul) {
    const int nblk = N / 32, kb = item / nblk, nb = item % nblk, k0 = 64 * kb, n0 = 32 * nb;
    const float nm = (NQ && n0 < 1024) ? QSCALE : 1.f;
#pragma unroll 8
    for (int i = 0; i < 32; ++i) { const int kk = 2 * i + (lane >> 5); float sc = nm; if (ks) sc *= ((const GASP float*)ks)[(k0 + kk) & kmask] * kmul;
        scr[kk * 33 + (lane & 31)] = ((const GASP float*)W)[(size_t)(k0 + kk) * N + n0 + (lane & 31)] * sc; }
    const int c = lane & 7;
#pragma unroll
    for (int j = 0; j < 4; ++j) { const int n = (lane >> 3) + 8 * j; const LAS float* s = scr + (8 * c) * 33 + n;
        U4 o; o.x = cvtpk(s[0 * 33], s[1 * 33]); o.y = cvtpk(s[2 * 33], s[3 * 33]); o.z = cvtpk(s[4 * 33], s[5 * 33]); o.w = cvtpk(s[6 * 33], s[7 * 33]);
        const int nn = n0 + n; const int row = (MODE == 0) ? nn : ((nn >> 7) * 256 + (MODE == 2 ? 128 : 0) + (nn & 127));
        *(GASP U4*)(WT + (size_t)row * K + k0 + 8 * c) = o; }
}

__device__ __forceinline__ void row_to_bf16_rs(const float* xrow, bf16* orow, float* rs, int lane) {
    const GASP F4* xr = (const GASP F4*)xrow + lane;
    F4 v[4]; float s = 0.f;
#pragma unroll
    for (int j = 0; j < 4; ++j) { v[j] = xr[64 * j]; s += (v[j].x * v[j].x + v[j].y * v[j].y) + (v[j].z * v[j].z + v[j].w * v[j].w); }
    const float rstd = rsqrtf(wave_sum(s) * (1.f / D) + RMS_EPS);
    GASP U2* o8 = (GASP U2*)orow + lane;
#pragma unroll
    for (int j = 0; j < 4; ++j) o8[64 * j] = (U2){cvtpk(v[j].x, v[j].y), cvtpk(v[j].z, v[j].w)};
    if (lane == 0) *(GASP float*)rs = rstd;
}

__device__ __forceinline__ F4 bf4(U2 w) { return (F4){__uint_as_float(w.x << 16), __uint_as_float(w.x & 0xffff0000u), __uint_as_float(w.y << 16), __uint_as_float(w.y & 0xffff0000u)}; }
template <bool OUT_F32>
__device__ __forceinline__ void resid_rows2(const bf16* M, bf16* R, float* out, float* RS, const float* g, int m0, int m1, int lane) {
    const int mm[2] = {m0, m1};
    F4 mv[2][4], xv[2][4];
#pragma unroll
    for (int q = 0; q < 2; ++q) { const int m = mm[q]; const GASP U2* mr = (const GASP U2*)(M + (size_t)m * D) + lane; const GASP U2* rr = (const GASP U2*)(R + (size_t)m * D) + lane;
#pragma unroll
        for (int j = 0; j < 4; ++j) { mv[q][j] = bf4(mr[64 * j]); xv[q][j] = bf4(rr[64 * j]); } }
    const GASP F4* gr = (const GASP F4*)g + lane;
#pragma unroll
    for (int q = 0; q < 2; ++q) { const int m = mm[q]; float s = 0.f;
#pragma unroll
        for (int j = 0; j < 4; ++j) s += (mv[q][j].x * mv[q][j].x + mv[q][j].y * mv[q][j].y) + (mv[q][j].z * mv[q][j].z + mv[q][j].w * mv[q][j].w);
        const float rstd = rsqrtf(wave_sum(s) * (1.f / D) + RMS_EPS); float s2 = 0.f;
#pragma unroll
        for (int j = 0; j < 4; ++j) { const F4 gv = gr[64 * j]; xv[q][j] = xv[q][j] + mv[q][j] * rstd * gv; s2 += (xv[q][j].x * xv[q][j].x + xv[q][j].y * xv[q][j].y) + (xv[q][j].z * xv[q][j].z + xv[q][j].w * xv[q][j].w); }
        if (OUT_F32) { GASP F4* orow = (GASP F4*)(out + (size_t)m * D) + lane;
#pragma unroll
            for (int j = 0; j < 4; ++j) orow[64 * j] = xv[q][j]; }
        else { GASP U2* rw = (GASP U2*)(R + (size_t)m * D) + lane;
#pragma unroll
            for (int j = 0; j < 4; ++j) rw[64 * j] = (U2){cvtpk(xv[q][j].x, xv[q][j].y), cvtpk(xv[q][j].z, xv[q][j].w)};
            const float r2 = rsqrtf(wave_sum(s2) * (1.f / D) + RMS_EPS); if (lane == 0) ((GASP float*)RS)[m] = r2; } }
}

__device__ __forceinline__ void na_phase(LAS unsigned char* lds, const bf16* Q, const bf16* Kb, const bf16* Vb, bf16* O, const float* rpb, int G, int wave, int lane) {
    const int r32 = lane & 31, hi = lane >> 5;
    LAS unsigned char* vbuf = lds + wave * 16384;
    LAS float* rpbL = (LAS float*)(lds + 131072 + wave * 2048);
    LAS float* wsf = (LAS float*)(lds + 147456 + wave * 128);
    LAS bf16* ost = (LAS bf16*)vbuf;
    const lds_cptr vp = (lds_cptr)vbuf + ((lane >> 4) & 1) * 32 + (lane & 3) * 8 + (4 * hi + ((lane & 15) >> 2)) * 64;
    const int blk = blockIdx.x;
    int x, c, ncx, nX; if (G % 8 == 0) { x = blk % 8; c = blk / 8; ncx = G / 8; nX = 8; } else { x = 0; c = blk; ncx = G; nX = 1; }
    const int per = 3072 / nX;
    int cur_h = -1;
    for (int li = c; li < per; li += ncx) {
        const int U = x * per + li, R = U >> 1, h = 8 * (U & 1) + wave;
        if (h != cur_h) { for (int i = lane; i < 465; i += 64) rpbL[i] = ((const GASP float*)rpb)[h * 465 + i] * LOG2E; cur_h = h; }
        int r, nrows; if (R < 1024) { r = R & 63; nrows = 64; } else { r = (R - 1024) & 255; nrows = 256; }
        const int Rbase = R - r; const int row0 = min(max(r - 4, 0), nrows - 8);
        {
            H8 qfa[4], qfb[4];
#pragma unroll
            for (int d0 = 0; d0 < 4; ++d0) { qfa[d0] = *(const GASP H8*)(Q + ((size_t)h * T + (size_t)R * 64 + r32) * 64 + 16 * d0 + 8 * hi); qfb[d0] = *(const GASP H8*)(Q + ((size_t)h * T + (size_t)R * 64 + 32 + r32) * 64 + 16 * d0 + 8 * hi); }
            float ma = NEGBIG, mb = NEGBIG, la = 0.f, lb = 0.f; F16 oa[2], ob[2]; oa[0] = F16{}; oa[1] = F16{}; ob[0] = F16{}; ob[1] = F16{};
            H8 kn[8];
            const char* kub = (const char*)Kb + ((size_t)h * T + (size_t)(Rbase + row0) * 64) * 128;
            const char* vub = (const char*)Vb + ((size_t)h * T + (size_t)(Rbase + row0) * 64) * 128;
            const unsigned kofs = (unsigned)((r32 * 64 + 8 * hi) * 2);
            const unsigned vofs = (unsigned)(((lane >> 2) * 64 + (lane & 3) * 8) * 2);
#define NA_KLOAD() do { _Pragma("unroll") for (int d0 = 0; d0 < 4; ++d0) { kn[2 * d0] = *(const GASP H8*)(kub + kofs + 32 * d0); kn[2 * d0 + 1] = *(const GASP H8*)(kub + kofs + 32 * 128 + 32 * d0); } } while (0)
#define NA_VDMA(buf) do { _Pragma("unroll") for (int i_ = 0; i_ < 8; ++i_) \
        __builtin_amdgcn_global_load_lds((const unsigned*)(vub + vofs + (16 * (i_ & 3)) * 128 + (i_ >> 2) * 64), (LAS unsigned*)(vbuf + (buf) * 8192 + i_ * 1024), 16, 0, 0); } while (0)
#define NA_SCORES(QF, QB, P0, P1) do { P0 = F16{}; P1 = F16{}; \
        _Pragma("unroll") for (int d0 = 0; d0 < 4; ++d0) { P0 = __builtin_amdgcn_mfma_f32_32x32x16_bf16(kn[2 * d0], QF[d0], P0, 0, 0, 0); P1 = __builtin_amdgcn_mfma_f32_32x32x16_bf16(kn[2 * d0 + 1], QF[d0], P1, 0, 0, 0); } \
        const int qc_ = 32 * (QB) + r32, qs_ = min(max(qc_ - 8, 0), 48); \
        int uu = 4 * hi - qs_, uu2 = 4 * hi - qc_ + 15; asm volatile("" : "+v"(uu), "+v"(uu2)); \
        const LAS float* brow = rpbL + dr * 31 + uu2; \
        _Pragma("unroll") for (int g4 = 0; g4 < 4; ++g4) { float b0_[4], b1_[4]; \
            _Pragma("unroll") for (int e = 0; e < 4; ++e) { b0_[e] = brow[8 * g4 + e]; b1_[e] = brow[8 * g4 + e + 32]; } \
            _Pragma("unroll") for (int e = 0; e < 4; ++e) asm volatile("" : "+v"(b0_[e]), "+v"(b1_[e]));     \
            _Pragma("unroll") for (int e = 0; e < 4; ++e) { const int rr = 4 * g4 + e, kcst = 8 * g4 + e; \
                const bool v0 = (unsigned)(uu + kcst) < 16u, v1 = (unsigned)(uu + kcst + 32) < 16u; \
                const float s0 = P0[rr] + b0_[e], s1 = P1[rr] + b1_[e]; \
                P0[rr] = v0 ? s0 : NEGBIG; P1[rr] = v1 ? s1 : NEGBIG; } } } while (0)
#define NA_STORE(OO, LL, QB) do { int le_ = lane; asm volatile("" : "+v"(le_)); const int r32e = le_ & 31, hie = le_ >> 5;     \
        const float lt = half_swap_sum(LL); if (hie == 0) wsf[r32e] = 1.0f / lt; \
        _Pragma("unroll") for (int rr = 0; rr < 16; ++rr) { const float f = wsf[crow(rr, hie)]; const int orow = crow(rr, hie); \
            _Pragma("unroll") for (int db = 0; db < 2; ++db) { const unsigned w = cvtpk(OO[db][rr] * f, 0.f); ost[orow * 64 + db * 32 + r32e] = (bf16)(w & 0xffffu); } } \
        _Pragma("unroll") for (int i = 0; i < 4; ++i) { const int row = i * 8 + (le_ >> 3), ch = le_ & 7; const U4 v = *(const LAS U4*)(ost + row * 64 + ch * 8); \
            *(GASP U4*)(O + ((size_t)R * 64 + 32 * (QB) + row) * D + h * 64 + ch * 8) = v; } } while (0)
            NA_VDMA(0);
            NA_KLOAD();
#pragma unroll 1
            for (int kr = 0; kr < 8; ++kr) {
                asm volatile("s_waitcnt vmcnt(0)" ::: "memory");
                const int dr = row0 + kr - r + 7;
                {   F16 p0, p1; NA_SCORES(qfa, 0, p0, p1);
                    flash_step<2>(p0, p1, ma, la, oa, wsf, vp + (kr & 1) * 8192, r32, hi); }
                {   F16 p0, p1; NA_SCORES(qfb, 1, p0, p1);
                    if (kr < 7) { kub += 64 * 128; vub += 64 * 128;
                        if (kr & 1) NA_VDMA(0); else NA_VDMA(1);
                        NA_KLOAD(); }
                    flash_step<2>(p0, p1, mb, lb, ob, wsf, vp + (kr & 1) * 8192, r32, hi); }
            }
            NA_STORE(oa, la, 0);
            NA_STORE(ob, lb, 1);
#undef NA_VDMA
#undef NA_KLOAD
#undef NA_SCORES
#undef NA_STORE
        }
    }
}

__device__ __forceinline__ int t5_bucket(int rel) { const int n = rel < 0 ? -rel : rel; const int big = min(15, 2 + (31 - __clz(n * n | 1))); return (rel > 0 ? 16 : 0) + (n < 8 ? n : big); }
typedef float F2 __attribute__((ext_vector_type(2)));
#define DA_VREADS(v, vaddr, DB) do { _Pragma("unroll") for (int k_ = 0; k_ < 4; ++k_) { DS_RDTR(v[2 * k_], vaddr, (DB) * 4096 + k_ * 1024); DS_RDTR(v[2 * k_ + 1], vaddr, (DB) * 4096 + k_ * 1024 + 512); } } while (0)
#define DA_VMFMA(v, DB) do { _Pragma("unroll") for (int k_ = 0; k_ < 4; ++k_) { const H8 vf_ = (H8){v[2 * k_][0], v[2 * k_][1], v[2 * k_][2], v[2 * k_][3], v[2 * k_ + 1][0], v[2 * k_ + 1][1], v[2 * k_ + 1][2], v[2 * k_ + 1][3]}; \
        o[DB] = __builtin_amdgcn_mfma_f32_32x32x16_bf16(__builtin_bit_cast(H8, pw[k_]), vf_, o[DB], 0, 0, 0); } } while (0)
__device__ __forceinline__ void da_pv(F16 (&o)[4], const U4 (&pw)[4], S4 (&va)[8], S4 (&vb)[8], unsigned vaddr) {
    LGKM_WAIT(0); SCHED_FENCE(); DA_VMFMA(va, 0); SCHED_FENCE();
    DA_VREADS(va, vaddr, 2); SCHED_FENCE(); DA_VMFMA(vb, 1); SCHED_FENCE();
    DA_VREADS(vb, vaddr, 3); LGKM_WAIT(8); SCHED_FENCE(); DA_VMFMA(va, 2); SCHED_FENCE();
    LGKM_WAIT(0); SCHED_FENCE(); DA_VMFMA(vb, 3); SCHED_FENCE();
}
#define DA_ILV() do { _Pragma("unroll") for (int g_ = 0; g_ < 4; ++g_) { __builtin_amdgcn_sched_group_barrier(0x008, 1, 0); __builtin_amdgcn_sched_group_barrier(0x002, 4, 0); } } while (0)
#define DA_EXP8(P, B, acc) do { _Pragma("unroll") for (int r_ = 0; r_ < 8; ++r_) { P[(B) + r_] = __builtin_amdgcn_exp2f(P[(B) + r_]); acc += P[(B) + r_]; } } while (0)
__device__ __forceinline__ float fadd_s(float a, float b) { float r; asm("v_add_f32_e32 %0, %1, %2" : "=v"(r) : "v"(a), "v"(b)); return r; }
#define DA_GAP(v, DB, K_, P, B, acc) do { const H8 vf_ = (H8){v[2 * (K_)][0], v[2 * (K_)][1], v[2 * (K_)][2], v[2 * (K_)][3], v[2 * (K_) + 1][0], v[2 * (K_) + 1][1], v[2 * (K_) + 1][2], v[2 * (K_) + 1][3]}; \
        o[DB] = __builtin_amdgcn_mfma_f32_32x32x16_bf16(__builtin_bit_cast(H8, pw[K_]), vf_, o[DB], 0, 0, 0); \
        P[(B)] = __builtin_amdgcn_exp2f(P[(B)]); P[(B) + 1] = __builtin_amdgcn_exp2f(P[(B) + 1]); acc += P[(B)]; acc += P[(B) + 1]; SCHED_FENCE(); } while (0)
#define DA_GROUP(v, DB, P, B, acc) do { DA_GAP(v, DB, 0, P, (B), acc); DA_GAP(v, DB, 1, P, (B) + 2, acc); DA_GAP(v, DB, 2, P, (B) + 4, acc); DA_GAP(v, DB, 3, P, (B) + 6, acc); } while (0)
#define DA_PACK8(P, B) (U4){cvtpk(P[(B)], P[(B) + 1]), cvtpk(P[(B) + 2], P[(B) + 3]), cvtpk(P[(B) + 4], P[(B) + 5]), cvtpk(P[(B) + 6], P[(B) + 7])}
__device__ __forceinline__ void da_phase(LAS unsigned char* lds, const bf16* Q, const bf16* Kb, const bf16* Vb, bf16* O, const float* lq1, const float* lk1, const float* lq2, const float* lk2,
                                         const float* t5, int G, int wave, int lane, int tid) {
    const int r32 = lane & 31, hi = lane >> 5, comp = wave >> 2, w4 = wave & 3;
    constexpr int KS = 0, VS = 49152;
    LAS bf16* ost = (LAS bf16*)(lds + 114688 + w4 * 8192);
    LAS float* lut = (LAS float*)(lds + 147456);
    LAS float* wsf = (LAS float*)(lds + 149504 + wave * 128);
    const float lam = __builtin_expf(wave_sum(lq1[lane] * lk1[lane])) - __builtin_expf(wave_sum(lq2[lane] * lk2[lane])) + LAMBDA_INIT;
    const int blk = blockIdx.x;
    int x, c, ncx, nX; if (G % 8 == 0) { x = blk % 8; c = blk / 8; ncx = G / 8; nX = 8; } else { x = 0; c = blk; ncx = G; nX = 1; }
    const int perP = 4096 / nX, perS = 2048 / nX, per = perP + perS;
    const int vlane = ((lane >> 4) & 1) * 32 + (lane & 3) * 8 + (4 * hi + ((lane & 15) >> 2)) * 64;
    const unsigned ldsb = (unsigned)(uintptr_t)lds;
    int cur_h = -1;
    for (int li = c; li < per; li += ncx) {
        int b, h, qb, S; size_t tok0;
        if (li < perP) { const int gi = x * perP + li; const int pair = gi >> 5; qb = gi & 31; b = pair >> 3; h = pair & 7; S = S_P; tok0 = (size_t)b * S_P; }
        else { const int gi = x * perS + (li - perP); const int pair = gi >> 7; qb = gi & 127; b = pair >> 3; h = pair & 7; S = S_S; tok0 = (size_t)T_P + (size_t)b * S_S; }
        if (h != cur_h) { __syncthreads(); for (int i = tid; i < 257; i += 512) lut[i] = ((const GASP float*)t5)[t5_bucket(i - 128) * 8 + h] * LOG2E; __syncthreads(); cur_h = h; }
        const int qrow0 = qb * 128 + 32 * w4;
        H8 qf[4];
#pragma unroll
        for (int d0 = 0; d0 < 4; ++d0) qf[d0] = *(const GASP H8*)(Q + ((size_t)h * T + tok0 + qrow0 + r32) * 128 + comp * 64 + 16 * d0 + 8 * hi);
        float m = 0.f, l = 0.f; F16 o[4];
#pragma unroll
        for (int db = 0; db < 4; ++db) o[db] = F16{};
        int cur_cls = -1; float cb = 0.f, cbm = 0.f;
        U4 pw[4] = {};
        const int NT = S / 64;
        const char* kub = (const char*)Kb + (((size_t)h * T + tok0 + 32 * (wave & 1)) * 128 + (wave >> 2) * 64 + ((wave >> 1) & 1) * 32) * 2;
        const char* vub = (const char*)Vb + (((size_t)h * T + tok0 + 16 * ((2 * wave) & 3)) * 128 + ((2 * wave) >> 2) * 32) * 2;
        const unsigned kofs = (unsigned)(((lane >> 2) * 128 + ((lane & 3) ^ ((lane >> 4) & 3)) * 8) * 2);
        const unsigned vofs = (unsigned)(((lane >> 2) * 128 + (lane & 3) * 8) * 2);
#define DA_DMA_K(tt, kslot) do { const char* kb_ = kub + (size_t)(tt) * (64 * 128 * 2); \
        __builtin_amdgcn_global_load_lds((const unsigned*)(kb_ + kofs), (LAS unsigned*)(lds + KS + (kslot) * 16384 + (2 * wave) * 1024), 16, 0, 0); \
        __builtin_amdgcn_global_load_lds((const unsigned*)(kb_ + 16 * 128 * 2 + kofs), (LAS unsigned*)(lds + KS + (kslot) * 16384 + (2 * wave + 1) * 1024), 16, 0, 0); } while (0)
#define DA_DMA_V(tt, vslot) do { const char* vb_ = vub + (size_t)(tt) * (64 * 128 * 2); \
        __builtin_amdgcn_global_load_lds((const unsigned*)(vb_ + vofs), (LAS unsigned*)(lds + VS + (vslot) * 16384 + (2 * wave) * 1024), 16, 0, 0); \
        __builtin_amdgcn_global_load_lds((const unsigned*)(vb_ + 16 * 128 * 2 + vofs), (LAS unsigned*)(lds + VS + (vslot) * 16384 + (2 * wave + 1) * 1024), 16, 0, 0); } while (0)
#define DA_DMA(tt, kslot, vslot) do { DA_DMA_K(tt, kslot); DA_DMA_V(tt, vslot); } while (0)
        DA_DMA(0, 0, 0); DA_DMA(1, 1, 1);
        int ks_cur = 0, ks_n2 = 2;
        const unsigned kswz = (unsigned)((hi ^ ((r32 >> 2) & 3)) * 16);
        const unsigned ka_base = ldsb + KS + comp * 8192 + r32 * 64;
        S4 va[8], vb[8];
#pragma unroll 1
        for (int t = 0; t < NT; ++t) {
            if (t + 1 < NT) asm volatile("s_waitcnt vmcnt(4)" ::: "memory"); else asm volatile("s_waitcnt vmcnt(0)" ::: "memory");
            __builtin_amdgcn_s_barrier();
            asm volatile("" ::: "memory");
            const unsigned vaddr_p = ldsb + VS + ((t == 0 ? 0 : t + 3) & 3) * 16384 + vlane;
            U4 kf[4];
            const unsigned ka0 = ka_base + ks_cur * 16384 + kswz, ka1 = ka_base + ks_cur * 16384 + (kswz ^ 32u);
            DS_RD128(kf[0], ka0, 0); DS_RD128(kf[1], ka1, 0); DS_RD128(kf[2], ka0, 4096); DS_RD128(kf[3], ka1, 4096);
            DA_VREADS(va, vaddr_p, 0); DA_VREADS(vb, vaddr_p, 1);
            const int kv0 = 64 * t; const int relmin = kv0 - (qrow0 + 31), relmax = kv0 + 63 - qrow0;
            const int cls = (relmin >= 128) ? 2 : ((relmax <= -128) ? 0 : 1);
            if (cls != cur_cls) { cur_cls = cls; cb = (cls == 2) ? lut[256] : ((cls == 0) ? lut[0] : 0.f); cbm = cb - m; }
            F16 p0, p1;
            {   typedef float F2i __attribute__((ext_vector_type(2))); F2i c2 = {cbm, cbm}; asm volatile("" : "+v"(c2));
#pragma unroll
                for (int r = 0; r < 16; r += 2) { p0[r] = c2.x; p0[r + 1] = c2.y; p1[r] = c2.x; p1[r + 1] = c2.y; } }
            asm volatile("s_waitcnt lgkmcnt(15)" ::: "memory"); SCHED_FENCE();
#pragma unroll
            for (int d0 = 0; d0 < 4; ++d0) p0 = __builtin_amdgcn_mfma_f32_32x32x16_bf16(__builtin_bit_cast(H8, kf[d0]), qf[d0], p0, 0, 0, 0);
            SCHED_FENCE();
            DS_RD128(kf[0], ka0, 2048); DS_RD128(kf[1], ka1, 2048); DS_RD128(kf[2], ka0, 6144); DS_RD128(kf[3], ka1, 6144);
            if (t + 2 < NT) DA_DMA_K(t + 2, ks_n2);
            LGKM_WAIT(0); SCHED_FENCE();
            float a0;
            p1 = __builtin_amdgcn_mfma_f32_32x32x16_bf16(__builtin_bit_cast(H8, kf[0]), qf[0], p1, 0, 0, 0); a0 = __builtin_fmaxf(__builtin_fmaxf(p0[0], p0[1]), p0[2]); a0 = __builtin_fmaxf(__builtin_fmaxf(a0, p0[3]), p0[4]); asm volatile("" : "+v"(a0)); SCHED_FENCE();
            p1 = __builtin_amdgcn_mfma_f32_32x32x16_bf16(__builtin_bit_cast(H8, kf[1]), qf[1], p1, 0, 0, 0); a0 = __builtin_fmaxf(__builtin_fmaxf(a0, p0[5]), p0[6]); a0 = __builtin_fmaxf(__builtin_fmaxf(a0, p0[7]), p0[8]); asm volatile("" : "+v"(a0)); SCHED_FENCE();
            p1 = __builtin_amdgcn_mfma_f32_32x32x16_bf16(__builtin_bit_cast(H8, kf[2]), qf[2], p1, 0, 0, 0); a0 = __builtin_fmaxf(__builtin_fmaxf(a0, p0[9]), p0[10]); a0 = __builtin_fmaxf(__builtin_fmaxf(a0, p0[11]), p0[12]); asm volatile("" : "+v"(a0)); SCHED_FENCE();
            p1 = __builtin_amdgcn_mfma_f32_32x32x16_bf16(__builtin_bit_cast(H8, kf[3]), qf[3], p1, 0, 0, 0); a0 = __builtin_fmaxf(__builtin_fmaxf(a0, p0[13]), p0[14]); a0 = __builtin_fmaxf(a0, p0[15]); asm volatile("" : "+v"(a0)); SCHED_FENCE();
            if (t + 2 < NT) DA_DMA_V(t + 2, (t + 2) & 3);
            if (cls == 1) { const int base = kv0 - (qrow0 + r32) + 128;
#pragma unroll
                for (int r = 0; r < 16; ++r) { const int i0 = base + crow(r, hi), i1 = i0 + 32;
                    p0[r] += lut[min(max(i0, 0), 256)]; p1[r] += lut[min(max(i1, 0), 256)];
                    if ((r & 1) == 1) asm volatile("" ::: "memory"); }
                a0 = __builtin_fmaxf(__builtin_fmaxf(p0[0], p0[1]), p0[2]);
#pragma unroll
                for (int r = 3; r < 15; r += 2) a0 = __builtin_fmaxf(__builtin_fmaxf(a0, p0[r]), p0[r + 1]);
                a0 = __builtin_fmaxf(a0, p0[15]); }
            float a1 = __builtin_fmaxf(__builtin_fmaxf(p1[0], p1[1]), p1[2]);
#pragma unroll
            for (int r = 3; r < 15; r += 2) a1 = __builtin_fmaxf(__builtin_fmaxf(a1, p1[r]), p1[r + 1]);
            a1 = __builtin_fmaxf(a1, p1[15]);
            const float rml = __builtin_fmaxf(a0, a1);
            if (t == 0 || __any(rml > 8.0f)) {
                const float rm = half_swap_max(rml);
                const float dl = (t == 0) ? rm : __builtin_fmaxf(rm, 0.f); m += dl;
#pragma unroll
                for (int r = 0; r < 16; ++r) { p0[r] -= dl; p1[r] -= dl; }
                cbm = cb - m;
                const float f = __builtin_amdgcn_exp2f(-dl); l *= f;
#pragma unroll
                for (int k = 0; k < 4; ++k)
#pragma unroll
                    for (int e = 0; e < 4; ++e) { const unsigned w = pw[k][e]; pw[k][e] = cvtpk(__uint_as_float(w << 16) * f, __uint_as_float(w & 0xffff0000u) * f); }
                if (hi == 0) wsf[r32] = f;
#pragma unroll
                for (int r = 0; r < 16; ++r) { const float fr = wsf[crow(r, hi)];
#pragma unroll
                    for (int db = 0; db < 4; ++db) o[db][r] *= fr; }
            }
            float sa = 0.f, sb = 0.f;
            SCHED_FENCE(); DA_GROUP(va, 0, p0, 0, sa);
            DA_VREADS(va, vaddr_p, 2); SCHED_FENCE();
            DA_GROUP(vb, 1, p0, 8, sa);
            DA_VREADS(vb, vaddr_p, 3); LGKM_WAIT(8); SCHED_FENCE();
            DA_GROUP(va, 2, p1, 0, sa);
            LGKM_WAIT(0); SCHED_FENCE();
            DA_GROUP(vb, 3, p1, 8, sa);
            l += sa + sb;
            pw[0] = DA_PACK8(p0, 0); pw[1] = DA_PACK8(p0, 8); pw[2] = DA_PACK8(p1, 0); pw[3] = DA_PACK8(p1, 8);
            ks_cur = (ks_cur == 2) ? 0 : ks_cur + 1; ks_n2 = (ks_n2 == 2) ? 0 : ks_n2 + 1;
        }
        {   const unsigned vaddr = ldsb + VS + ((NT - 1) & 3) * 16384 + vlane; DA_VREADS(va, vaddr, 0); DA_VREADS(vb, vaddr, 1); da_pv(o, pw, va, vb, vaddr); }
#undef DA_DMA
#undef DA_DMA_K
#undef DA_DMA_V
        int lane_e = lane; asm volatile("" : "+v"(lane_e));
        const int r32e = lane_e & 31, hie = lane_e >> 5;
        const float lt = half_swap_sum(l);
        if (hie == 0) wsf[r32e] = (comp == 0 ? 1.0f : -lam) / lt;
#pragma unroll
        for (int r = 0; r < 16; ++r) { const float f = wsf[crow(r, hie)];
#pragma unroll
            for (int db = 0; db < 4; ++db) o[db][r] *= f; }
        __syncthreads();
        LAS float* xb = (LAS float*)lds + w4 * 4096;
        if (comp == 1) {
#pragma unroll
            for (int db = 0; db < 4; ++db)
#pragma unroll
                for (int r = 0; r < 16; ++r) xb[(db * 16 + r) * 64 + lane_e] = o[db][r];
        }
        __syncthreads();
        if (comp == 0) {
            float ss[16];
#pragma unroll
            for (int r = 0; r < 16; ++r) { float q = 0.f;
#pragma unroll
                for (int db = 0; db < 4; ++db) { o[db][r] += xb[(db * 16 + r) * 64 + lane_e]; q += o[db][r] * o[db][r]; }
                ss[r] = q; }
#pragma unroll
            for (int r = 0; r < 16; ++r) {
#pragma unroll
                for (int off = 1; off < 32; off <<= 1) ss[r] += __shfl_xor(ss[r], off);
                const float rs = rsqrtf(ss[r] * (1.0f / 128.0f) + RMS_EPS); const int orow = crow(r, hie);
#pragma unroll
                for (int db = 0; db < 4; ++db) { const unsigned w = cvtpk(o[db][r] * rs, 0.f); ost[orow * 128 + db * 32 + r32e] = (bf16)(w & 0xffffu); } }
#pragma unroll
            for (int i = 0; i < 8; ++i) { const int row = i * 4 + (lane_e >> 4), ch = lane_e & 15; const U4 v = *(const LAS U4*)(ost + row * 128 + ch * 8);
                *(GASP U4*)(O + (tok0 + qrow0 + row) * D + h * 128 + ch * 8) = v; }
        }
        __syncthreads();
    }
}

#define XB_TMO      128
#define XB_XCNT(j)  (256  + 64 * (j))
#define XB_XSUB(j)  (1280 + 64 * (j))
#define XB_XGEN(j)  (2304 + 64 * (j))
#define XB_TOP      3328
#define XB_TOPGEN   3392
#define XCD_BAR_WORDS 3456
#define XB_SPIN_CAP (1u << 18)

__device__ __forceinline__ unsigned xb_ld(unsigned* p)              { return __hip_atomic_load(p, __ATOMIC_RELAXED, __HIP_MEMORY_SCOPE_AGENT); }
__device__ __forceinline__ unsigned xb_add(unsigned* p, unsigned v) { return __hip_atomic_fetch_add(p, v, __ATOMIC_RELAXED, __HIP_MEMORY_SCOPE_AGENT); }
__device__ __forceinline__ unsigned xb_xcc_id() { return (unsigned)__builtin_amdgcn_s_getreg((3 << 11) | 20) & 0xFu; }
#define XB_SPIN(cond, bar) do { unsigned _sp = 0; while (cond) { __builtin_amdgcn_s_sleep(1); \
    if ((++_sp & 255u) == 0u) { if (xb_ld(&(bar)[XB_TMO])) break; if (_sp > XB_SPIN_CAP) { atomicAdd(&(bar)[XB_TMO], 1u); break; } } } } while (0)

struct XcdBarrier {
    unsigned* bar; unsigned x;
    volatile LAS unsigned* st;
};

__device__ __forceinline__ XcdBarrier xcd_barrier_post(unsigned* bar, volatile LAS unsigned* st, int xb_tid) {
    XcdBarrier b; b.bar = bar; b.x = xb_xcc_id(); b.st = st;
    if (xb_tid == 0) (void)xb_add(&bar[XB_XCNT(b.x)], 1u);
    return b;
}
__device__ __forceinline__ void xcd_barrier_complete(unsigned* bar, unsigned x, unsigned& nloc, unsigned& nx) {
    const unsigned G = gridDim.x * gridDim.y * gridDim.z;
    unsigned sum, cnt, mine, sp = 0u;
    for (;;) {
        sum = 0u; cnt = 0u; mine = 0u;
#pragma unroll
        for (unsigned j = 0; j < 16; ++j) { const unsigned c = xb_ld(&bar[XB_XCNT(j)]); sum += c; cnt += (c > 0u) ? 1u : 0u; mine = (j == x) ? c : mine; }
        if (sum == G) break;
        __builtin_amdgcn_s_sleep(1);
        if ((++sp & 255u) == 0u) { if (xb_ld(&bar[XB_TMO])) break; if (sp > XB_SPIN_CAP) { atomicAdd(&bar[XB_TMO], 1u); break; } }
    }
    nloc = mine > 0u ? mine : 1u; nx = cnt > 0u ? cnt : 1u;
}

__device__ __forceinline__ void xcd_barrier(const XcdBarrier& b, int xb_tid) {
    asm volatile("s_waitcnt vmcnt(0)" ::: "memory");
    __syncthreads();
    if (xb_tid == 0) {
        unsigned* bar = b.bar;
        __builtin_amdgcn_s_waitcnt(0);
        unsigned nloc = b.st[0], nx = b.st[1];
        if (nloc == 0u) { xcd_barrier_complete(bar, b.x, nloc, nx); b.st[0] = nloc; b.st[1] = nx; }
        const unsigned old = xb_add(&bar[XB_XSUB(b.x)], 1u);
        const unsigned gen = old / nloc;
        if (old + 1u == (gen + 1u) * nloc) {
            __builtin_amdgcn_fence(__ATOMIC_RELEASE, "agent");
            asm volatile("s_waitcnt vmcnt(0)" ::: "memory");
            const unsigned og = xb_add(&bar[XB_TOP], 1u);
            const unsigned tg = og / nx;
            if (og + 1u == (tg + 1u) * nx) xb_add(&bar[XB_TOPGEN], 1u);
            else XB_SPIN(xb_ld(&bar[XB_TOPGEN]) == tg, bar);
            __builtin_amdgcn_fence(__ATOMIC_ACQUIRE, "agent");
            xb_add(&bar[XB_XGEN(b.x)], 1u);
            asm volatile("s_waitcnt vmcnt(0)" ::: "memory");
        } else {
            XB_SPIN(xb_ld(&bar[XB_XGEN(b.x)]) == gen, bar);
            __builtin_amdgcn_fence(__ATOMIC_ACQUIRE, "agent");
            asm volatile("s_waitcnt vmcnt(0)" ::: "memory");
        }
    }
    __syncthreads();
}

#define GAS __attribute__((address_space(1)))
template <class Tp> __device__ __forceinline__ Tp* gptr(Tp* p) { return (Tp*)(GAS Tp*)p; }
struct Args { const float* in[20]; float* out; unsigned char* ws; };
__global__ void __launch_bounds__(NWAVES * 64, 2) mega_fwd(Args a) {
    extern __shared__ __attribute__((aligned(16))) unsigned char lds_raw[];
    LAS unsigned char* lds = (LAS unsigned char*)lds_raw;
    cg::grid_group grid = cg::this_grid();
    const int G = gridDim.x;
    const int wave0 = __builtin_amdgcn_readfirstlane((int)threadIdx.x >> 6);
    volatile LAS unsigned* xb_st = (volatile LAS unsigned*)(lds + LDS_BYTES - 16);
    if (threadIdx.x == 0) { xb_st[0] = 0u; xb_st[1] = 0u; }
    __syncthreads();
    (void)xcd_barrier_post((unsigned*)(gptr(a.ws) + WS_CTL), xb_st, (int)threadIdx.x);
#define GRID_SYNC() do { XcdBarrier xb_; unsigned char* wsb_ = a.ws; asm volatile("" : "+s"(wsb_)); xb_.bar = (unsigned*)(gptr(wsb_) + WS_CTL); xb_.x = xb_xcc_id(); xb_.st = (volatile LAS unsigned*)(lds + LDS_BYTES - 16); \
        unsigned on_ = ~0u; asm volatile("" : "+s"(on_)); xcd_barrier(xb_, wave0 * 64 + (int)__builtin_amdgcn_mbcnt_hi(on_, __builtin_amdgcn_mbcnt_lo(on_, 0u))); } while (0)
#define PHASE_IDS() unsigned ones_ = ~0u; asm volatile("" : "+s"(ones_)); int tid = wave0 * 64 + (int)__builtin_amdgcn_mbcnt_hi(ones_, __builtin_amdgcn_mbcnt_lo(ones_, 0u)); asm volatile("" : "+v"(tid)); const int lane = tid & 63, wave = wave0; \
    const int gw = blockIdx.x * NWAVES + wave, NGW = G * NWAVES; (void)gw; (void)NGW; (void)lane; \
    unsigned char* ws0_ = a.ws; asm volatile("" : "+s"(ws0_)); unsigned char* ws = gptr(ws0_); \
    bf16* XN = (bf16*)(ws + WS_XN); bf16* QO = (bf16*)(ws + WS_QO); bf16* KB = (bf16*)(ws + WS_K); bf16* VB = (bf16*)(ws + WS_V); bf16* ACT = (bf16*)(ws + WS_ACT); bf16* OB = (bf16*)(ws + WS_O); bf16* RB = (bf16*)(ws + WS_R); float* RS = (float*)(ws + WS_RS); (void)OB; (void)RB; (void)RS; \
    (void)XN; (void)QO; (void)KB; (void)VB; (void)ACT

#ifndef REP_PRO
#define REP_PRO 1
#endif
#ifndef REP_NORM
#define REP_NORM 1
#endif
#ifndef EXTRA_SYNC
#define EXTRA_SYNC 0
#endif
#pragma unroll 1
    for (int rep = 0; rep < REP_PRO; ++rep)
    {
        PHASE_IDS();
        const float* xp = gptr(a.in[0]); const float* xs = gptr(a.in[1]);
        LAS float* scr = (LAS float*)(lds + wave * 16384);
        constexpr int I_QKV = 16 * 96, I_O = 16 * 32, I_G = 16 * 88, I_D = 44 * 32, I_L = I_QKV + I_O + 2 * I_G + I_D;
#pragma unroll 1
        for (int it = gw; it < 2 * I_L; it += NGW) {
            const int L = it / I_L; int r = it % I_L;
            if (r < I_QKV) { tr_item<0, true>(L == 0 ? gptr(a.in[4]) : gptr(a.in[7]), D, NQKV, (bf16*)(ws + (L == 0 ? WS_WQKV0 : WS_WQKV1)), scr, r, lane, gptr(a.in[2]) + L * D, 1023, 1.f); continue; } r -= I_QKV;
            if (r < I_O) { tr_item<0, false>(L == 0 ? gptr(a.in[5]) : gptr(a.in[8]), D, D, (bf16*)(ws + (L == 0 ? WS_WO0 : WS_WO1)), scr, r, lane, L == 0 ? nullptr : gptr(a.in[13]), 127, 1.0f - LAMBDA_INIT); continue; } r -= I_O;
            if (r < I_G) { tr_item<1, false>(gptr(a.in[17]) + (size_t)L * D * FF, D, FF, (bf16*)(ws + (L == 0 ? WS_WGU0 : WS_WGU1)), scr, r, lane, gptr(a.in[15]) + L * D, 1023, 1.f); continue; } r -= I_G;
            if (r < I_G) { tr_item<2, false>(gptr(a.in[18]) + (size_t)L * D * FF, D, FF, (bf16*)(ws + (L == 0 ? WS_WGU0 : WS_WGU1)), scr, r, lane, gptr(a.in[15]) + L * D, 1023, 1.f); continue; } r -= I_G;
            tr_item<0, false>(gptr(a.in[19]) + (size_t)L * FF * D, FF, D, (bf16*)(ws + (L == 0 ? WS_WD0 : WS_WD1)), scr, r, lane, nullptr, 0, 1.f);
        }
#pragma unroll 1
        for (int m = gw; m < T; m += NGW) row_to_bf16_rs(m < T_P ? xp + (size_t)m * D : xs + (size_t)(m - T_P) * D, RB + (size_t)m * D, RS + m, lane);
    }
    grid.sync();
#pragma unroll 1
    for (int rep = 0; rep < EXTRA_SYNC; ++rep) GRID_SYNC();

#pragma unroll 1
    for (int L = 0; L < 2; ++L) {
#pragma unroll 1
        for (int rep = 0; rep < REP_GEMM; ++rep) {
        {   PHASE_IDS(); const bf16* Wqkv = (const bf16*)(ws + (L == 0 ? WS_WQKV0 : WS_WQKV1));
            pg8::Gemm g{RB, Wqkv, T, NQKV, D}; pg8::StaticOrder S; S.init(T, NQKV, G, (int)blockIdx.x);
            pg8::EpiQKV E{QO, (size_t)(WS_K - WS_QO) / 2, L == 0 ? 6 : 7, T, RS};
            pg8::gemm_phase<pg8::EpiQKV, pg8::StaticOrder, true, true>(lds, g, S, E, tid); }
        GRID_SYNC(); }
        if (L == 0) {
#pragma unroll 1
            for (int rep = 0; rep < REP_NA; ++rep) { { PHASE_IDS(); na_phase(lds, QO, KB, VB, OB, gptr(a.in[6]), G, wave, lane); } GRID_SYNC(); }
        } else {
#pragma unroll 1
            for (int rep = 0; rep < REP_DA; ++rep) { { PHASE_IDS(); da_phase(lds, QO, KB, VB, OB, gptr(a.in[9]), gptr(a.in[10]), gptr(a.in[11]), gptr(a.in[12]), gptr(a.in[14]), G, wave, lane, tid); } GRID_SYNC(); }
        }
#pragma unroll 1
        for (int rep = 0; rep < REP_GEMM; ++rep) {
        {   PHASE_IDS(); const bf16* Wo = (const bf16*)(ws + (L == 0 ? WS_WO0 : WS_WO1));
            pg8::Gemm g{OB, Wo, T, D, D}; pg8::StaticOrder S; S.init(T, D, G, (int)blockIdx.x);
            pg8::EpiBf16<0> E{KB, D, nullptr, 0, 0, 1.f};
            pg8::gemm_phase<pg8::EpiBf16<0>, pg8::StaticOrder, true, true>(lds, g, S, E, tid); }
        GRID_SYNC(); }
        {   PHASE_IDS(); const float* gp = gptr(a.in[3]) + L * D;
#pragma unroll 1
            for (int rep = 0; rep < REP_NORM; ++rep)
#pragma unroll 1
                for (int m = gw; m < T; m += 2 * NGW) resid_rows2<false>(KB, RB, nullptr, RS, gp, m, (m + NGW < T) ? m + NGW : m, lane);
        }
        GRID_SYNC();
#pragma unroll 1
        for (int rep = 0; rep < REP_GEMM; ++rep) {
        {   PHASE_IDS(); const bf16* Wgu = (const bf16*)(ws + (L == 0 ? WS_WGU0 : WS_WGU1));
            pg8::Gemm g{RB, Wgu, T, 2 * FF, D}; pg8::StaticOrder S; S.init(T, 2 * FF, G, (int)blockIdx.x);
            pg8::EpiSwiglu E{ACT, FF, RS};
            pg8::gemm_phase<pg8::EpiSwiglu, pg8::StaticOrder, true, true>(lds, g, S, E, tid); }
        GRID_SYNC(); }
#pragma unroll 1
        for (int rep = 0; rep < REP_GEMM; ++rep) {
        {   PHASE_IDS(); const bf16* Wd = (const bf16*)(ws + (L == 0 ? WS_WD0 : WS_WD1));
            pg8::Gemm g{ACT, Wd, T, D, FF}; pg8::StaticOrder S; S.init(T, D, G, (int)blockIdx.x);
            pg8::EpiBf16<0> E{XN, D, nullptr, 0, 0, 1.f};
            pg8::gemm_phase<pg8::EpiBf16<0>, pg8::StaticOrder, true, true>(lds, g, S, E, tid); }
        GRID_SYNC(); }
        {   PHASE_IDS(); float* out = gptr(a.out); const float* gp = gptr(a.in[16]) + L * D;
            if (L == 0) {
#pragma unroll 1
                for (int m = gw; m < T; m += 2 * NGW) resid_rows2<false>(XN, RB, nullptr, RS, gp, m, (m + NGW < T) ? m + NGW : m, lane);
            } else {
#pragma unroll 1
                for (int m = gw; m < T; m += 2 * NGW) resid_rows2<true>(XN, RB, out, RS, gp, m, (m + NGW < T) ? m + NGW : m, lane);
            } }
        if (L == 0) GRID_SYNC();
    }
}

extern "C" void kernel_launch(void* const* d_in, const int* in_sizes, int n_in, void* d_out, int out_size, void* d_ws, size_t ws_size, hipStream_t stream) {
    static int grid = 0;
    if (grid == 0) {
        if (n_in != 20 || out_size != T * D || ws_size < WS_END) { fprintf(stderr, "kernel_launch: unexpected problem (n_in %d, out %d, ws %zu)\n", n_in, out_size, ws_size); grid = -1; return; }
        int dev = 0, cus = 0, per_cu = 0;
        if (hipGetDevice(&dev) != hipSuccess || hipDeviceGetAttribute(&cus, hipDeviceAttributeMultiprocessorCount, dev) != hipSuccess) { grid = -1; return; }
        if (hipFuncSetAttribute((const void*)mega_fwd, hipFuncAttributeMaxDynamicSharedMemorySize, LDS_BYTES) != hipSuccess) { fprintf(stderr, "kernel_launch: hipFuncSetAttribute failed\n"); grid = -1; return; }
        if (hipOccupancyMaxActiveBlocksPerMultiprocessor(&per_cu, (const void*)mega_fwd, NWAVES * 64, LDS_BYTES) != hipSuccess || per_cu < 1) { fprintf(stderr, "kernel_launch: occupancy query says %d\n", per_cu); (void)hipGetLastError(); per_cu = 1; }
        grid = cus * per_cu;
    }
    if (grid < 0) return;
    Args a{};
    for (int i = 0; i < 20; ++i) a.in[i] = (const float*)d_in[i];
    a.out = (float*)d_out; a.ws = (unsigned char*)d_ws;
    if (hipMemsetAsync((char*)d_ws + WS_CTL, 0, CTL_BYTES, stream) != hipSuccess) { fprintf(stderr, "kernel_launch: hipMemsetAsync failed\n"); return; }
    void* args[] = {&a};
    hipError_t e = hipLaunchCooperativeKernel((const void*)mega_fwd, dim3(grid), dim3(NWAVES * 64), args, LDS_BYTES, stream);
    if (e != hipSuccess) fprintf(stderr, "kernel_launch: cooperative launch failed: %s (grid %d)\n", hipGetErrorString(e), grid);
}
```

```cpp
#include <hip/hip_runtime.h>
#include <hip/hip_cooperative_groups.h>
#include <hip/hip_bf16.h>
#include <cstdio>
#include <cstdint>
namespace cg = cooperative_groups;
namespace pg8 {
#define PG8_LAS __attribute__((address_space(3)))
typedef unsigned short bf16_t;
typedef short bf16x8 __attribute__((ext_vector_type(8)));
typedef float f32x4 __attribute__((ext_vector_type(4)));
typedef unsigned u32x4 __attribute__((ext_vector_type(4)));
constexpr int BM = 256, BK = 64, HALF = 128, HTB = HALF * BK * 2  , STAGE_BYTES = 8 * HTB, NXCD = 8, WGM = 8;

__host__ __device__ __forceinline__ int lds_byte(int r, int c) { const int st = (r >> 4) * 2 + (c >> 5), rr = r & 15, cc = c & 31, ob = rr * 64 + cc * 2; return st * 1024 + (ob ^ (((ob >> 9) & 1) << 5)); }
__host__ __device__ __forceinline__ void stage_rc(int b, int& R, int& C) { const int st = b / 1024, sb = b % 1024, swz = sb ^ (((sb >> 9) & 1) << 5); R = (st >> 1) * 16 + swz / 64; C = (st & 1) * 32 + (swz % 64) / 2; }
__host__ __device__ __forceinline__ int perm32(int rho) { const int n = rho >> 4, i = rho & 15; return 8 * (i >> 2) + 4 * n + (i & 3); }

struct Unit { int pm, pn; };
struct Gemm { const bf16_t* A; const bf16_t* Bt; int M, N, K; };

struct StaticOrder {
    int nM, nN, nwg, G, c;
    __host__ __device__ void init(int M, int N, int G_, int c_) { nM = M / BM; nN = N / BM; nwg = nM * nN; G = G_; c = c_; }
    __host__ __device__ bool next(int i, Unit& u) const {
        const long L = (long)i * G + c; if (L >= nwg) return false;
        int wgid = (int)L; { const int q = nwg / NXCD, r = nwg % NXCD, xcd = wgid % NXCD, off = wgid / NXCD; wgid = (xcd < r ? xcd * (q + 1) : r * (q + 1) + (xcd - r) * q) + off; }
        const int nig = WGM * nN, gid = wgid / nig, fm = gid * WGM, gsz = (nM - fm) < WGM ? (nM - fm) : WGM;
        u.pm = fm + ((wgid % nig) % gsz); u.pn = (wgid % nig) / gsz; return true;
    }
    __device__ __forceinline__ void a_ready(const Unit&) const {}
    __device__ __forceinline__ void done(const Unit&) const {}
};

__device__ __forceinline__ unsigned cvt_pk_bf16(float lo, float hi) { unsigned r; asm volatile("v_cvt_pk_bf16_f32 %0, %1, %2" : "=v"(r) : "v"(lo), "v"(hi)); return r; }
typedef float f32x2 __attribute__((ext_vector_type(2)));
__device__ __forceinline__ f32x2 gelu_pk(f32x2 v) {
    const f32x2 av = __builtin_elementwise_abs(v), d = av * 0.2316418882f + 1.0f;
    f32x2 t; t.x = __builtin_amdgcn_rcpf(d.x); t.y = __builtin_amdgcn_rcpf(d.y);
    f32x2 q = t * 0.5307027145f + (-0.7265760135f); q = q * t + 0.7107068705f; q = q * t + (-0.142248368f); q = q * t + 0.127414796f; q = q * t;
    const f32x2 s = (v * v) * (-0.72134752044f);
    f32x2 e; e.x = __builtin_amdgcn_exp2f(s.x); e.y = __builtin_amdgcn_exp2f(s.y);
    const f32x2 m = v * (q * e), r = v - m;
    f32x2 o; o.x = v.x < 0.f ? m.x : r.x; o.y = v.y < 0.f ? m.y : r.y; return o;
}

template <int ACT  > struct EpiBf16 {
    static constexpr bool PERM = true, AFTER_DRAIN = false; static_assert(ACT == 0 || ACT == 1, "EpiBf16: ACT is 0 (none) or 1 (gelu_pk)");
    bf16_t* O; int ldc; const float* bias; int split_cols; size_t split_stride; float scale0;
    __device__ __forceinline__ void operator()(const f32x4 (&acc)[2][2][4][2], const Unit& u, int wr, int wc, int fr, int fq) const {
        const int row0 = u.pm * BM + wr * 64 + fr; int colt = u.pn * BM; bf16_t* base = O;
        float sc = 1.f; if (split_cols) { const int t = colt / split_cols; base += (size_t)t * split_stride; colt -= t * split_cols; if (t == 0) sc = scale0; }
        const int col0 = colt + wc * 32 + 8 * fq, bcol0 = u.pn * BM + wc * 32 + 8 * fq;
        f32x4 bv[2][2];
#pragma unroll
        for (int bj = 0; bj < 2; ++bj)
#pragma unroll
            for (int n = 0; n < 2; ++n) bv[bj][n] = bias ? *(const f32x4*)(bias + bcol0 + bj * HALF + 4 * n) : (f32x4){0.f, 0.f, 0.f, 0.f};
#pragma unroll
        for (int ai = 0; ai < 2; ++ai)
#pragma unroll
            for (int m = 0; m < 4; ++m) { bf16_t* rowp = base + (size_t)(row0 + ai * HALF + m * 16) * ldc + col0;
#pragma unroll
                for (int bj = 0; bj < 2; ++bj) { f32x4 v0 = acc[ai][bj][m][0] + bv[bj][0], v1 = acc[ai][bj][m][1] + bv[bj][1];
                    if (ACT == 1) { f32x2 a = gelu_pk((f32x2){v0[0], v0[1]}), b = gelu_pk((f32x2){v0[2], v0[3]}), c = gelu_pk((f32x2){v1[0], v1[1]}), d = gelu_pk((f32x2){v1[2], v1[3]});
                        v0 = (f32x4){a.x, a.y, b.x, b.y}; v1 = (f32x4){c.x, c.y, d.x, d.y}; }
                    v0 = v0 * sc; v1 = v1 * sc; u32x4 w; w.x = cvt_pk_bf16(v0[0], v0[1]); w.y = cvt_pk_bf16(v0[2], v0[3]); w.z = cvt_pk_bf16(v1[0], v1[1]); w.w = cvt_pk_bf16(v1[2], v1[3]);
                    *(__attribute__((address_space(1))) u32x4*)(rowp + bj * HALF) = w; } }
    }
};
struct EpiSwiglu {
    static constexpr bool PERM = true, AFTER_DRAIN = false;
    bf16_t* O; int ldc; const float* rs;
    __device__ __forceinline__ void operator()(const f32x4 (&acc)[2][2][4][2], const Unit& u, int wr, int wc, int fr, int fq) const {
        const int row0 = u.pm * BM + wr * 64 + fr; const int col0 = u.pn * HALF + wc * 32 + 8 * fq;
        float scv[2][4];
#pragma unroll
        for (int ai = 0; ai < 2; ++ai)
#pragma unroll
            for (int m = 0; m < 4; ++m) scv[ai][m] = ((const __attribute__((address_space(1))) float*)rs)[row0 + ai * HALF + m * 16];
#pragma unroll
        for (int ai = 0; ai < 2; ++ai)
#pragma unroll
            for (int m = 0; m < 4; ++m) { bf16_t* rowp = O + (size_t)(row0 + ai * HALF + m * 16) * ldc + col0; const float sc = scv[ai][m], kx = -1.4426950408889634f * sc, sc2 = sc * sc;
                float v[8];
#pragma unroll
                for (int n = 0; n < 2; ++n)
#pragma unroll
                    for (int e = 0; e < 4; ++e) { const float ga = acc[ai][0][m][n][e], ua = acc[ai][1][m][n][e];
                        const float s = __builtin_amdgcn_rcpf(1.0f + __builtin_amdgcn_exp2f(kx * ga)); v[n * 4 + e] = (ga * ua) * (s * sc2); }
                u32x4 w; w.x = cvt_pk_bf16(v[0], v[1]); w.y = cvt_pk_bf16(v[2], v[3]); w.z = cvt_pk_bf16(v[4], v[5]); w.w = cvt_pk_bf16(v[6], v[7]);
                *(__attribute__((address_space(1))) u32x4*)rowp = w; }
    }
};
struct EpiQKV {
    static constexpr bool PERM = true, AFTER_DRAIN = false;
    bf16_t* O; size_t tstride; int hw_log2; int M; const float* rs;
    __device__ __forceinline__ void operator()(const f32x4 (&acc)[2][2][4][2], const Unit& u, int wr, int wc, int fr, int fq) const {
        const int row0 = u.pm * BM + wr * 64 + fr; const int colt = u.pn * BM; const int t = colt >> 10;
        bf16_t* base = O + (size_t)t * tstride; const int hw = 1 << hw_log2;
        float scv[2][4];
#pragma unroll
        for (int ai = 0; ai < 2; ++ai)
#pragma unroll
            for (int m = 0; m < 4; ++m) scv[ai][m] = ((const __attribute__((address_space(1))) float*)rs)[row0 + ai * HALF + m * 16];
#pragma unroll
        for (int bj = 0; bj < 2; ++bj) { const int col = (colt & 1023) + bj * HALF + wc * 32 + 8 * fq; const int head = col >> hw_log2, within = col & (hw - 1);
            bf16_t* hp = base + ((size_t)head * M << hw_log2) + within;
#pragma unroll
            for (int ai = 0; ai < 2; ++ai)
#pragma unroll
                for (int m = 0; m < 4; ++m) { const float sc = scv[ai][m]; const f32x4 v0 = acc[ai][bj][m][0] * sc, v1 = acc[ai][bj][m][1] * sc;
                    u32x4 w; w.x = cvt_pk_bf16(v0[0], v0[1]); w.y = cvt_pk_bf16(v0[2], v0[3]); w.z = cvt_pk_bf16(v1[0], v1[1]); w.w = cvt_pk_bf16(v1[2], v1[3]);
                    *(__attribute__((address_space(1))) u32x4*)(hp + ((size_t)(row0 + ai * HALF + m * 16) << hw_log2)) = w; } }
    }
};
template <class Epi, class Sched, bool ALIGN_EPI = false, bool SP2 = false>
__device__ __forceinline__ void gemm_phase(PG8_LAS unsigned char* lds, const Gemm g, const Sched& S, const Epi& E, int tid_in) {
    int tid_l = tid_in; asm volatile("" : "+v"(tid_l));
    const int tid = tid_l, wid = __builtin_amdgcn_readfirstlane(tid >> 6), lane = tid & 63, wr = wid >> 2, wc = wid & 3, fr = lane & 15, fq = lane >> 4;
    const int K = g.K, nt = K / BK;
    unsigned voffA[2], voffB[2];
#pragma unroll
    for (int i = 0; i < 2; ++i) { int R, C; stage_rc(tid * 16 + i * 8192, R, C); const int Rb = Epi::PERM ? ((R & ~31) + perm32(R & 31)) : R;
        voffA[i] = (unsigned)(R * K + C) * 2u; voffB[i] = (unsigned)(Rb * K + C) * 2u; }
    const size_t kstep = (size_t)(BK * 2);
    const size_t hstep = (size_t)HALF * K * 2;
    const size_t tstep = 2 * hstep;
    const unsigned ldsw = (unsigned)wid * 1024u;
    const int aoff = lds_byte(wr * 64 + fr, fq * 8), boff = lds_byte(wc * 32 + fr, fq * 8);
#define PG8_SA(b, h) (((b) * 2 + (h)) * HTB)
#define PG8_SB(b, h) ((4 + (b) * 2 + (h)) * HTB)
#define PG8_STAGE(bufoff, gbase, voff) do { _Pragma("unroll") for (int _i = 0; _i < 2; ++_i) \
        __builtin_amdgcn_global_load_lds((const unsigned*)((const char*)(gbase) + (voff)[_i]), (PG8_LAS unsigned*)(lds + (bufoff) + ldsw + _i * 8192), 16, 0, 0); } while (0)
#define PG8_LDA(dst, b, h) do { _Pragma("unroll") for (int m = 0; m < 4; ++m) _Pragma("unroll") for (int k = 0; k < 2; ++k) dst[m][k] = *(const PG8_LAS bf16x8*)(lds + PG8_SA(b, h) + aoff + m * 2048 + k * 1024); } while (0)
#define PG8_LDB(dst, b, h) do { _Pragma("unroll") for (int n = 0; n < 2; ++n) _Pragma("unroll") for (int k = 0; k < 2; ++k) dst[n][k] = *(const PG8_LAS bf16x8*)(lds + PG8_SB(b, h) + boff + n * 2048 + k * 1024); } while (0)
#define PG8_MMA(ai, bj, At, Bt) do { __builtin_amdgcn_s_setprio(1); _Pragma("unroll") for (int m = 0; m < 4; ++m) _Pragma("unroll") for (int n = 0; n < 2; ++n) _Pragma("unroll") for (int k = 0; k < 2; ++k) \
        acc[ai][bj][m][n] = __builtin_amdgcn_mfma_f32_16x16x32_bf16(Bt[n][k], At[m][k], acc[ai][bj][m][n], 0, 0, 0); __builtin_amdgcn_s_setprio(0); } while (0)
#define PG8_WAIT_V(n) asm volatile("s_waitcnt vmcnt(" #n ")" ::: "memory")
#define PG8_WAIT_L(n) asm volatile("s_waitcnt lgkmcnt(" #n ")" ::: "memory")
#define PG8_BAR __builtin_amdgcn_s_barrier()
#define PG8_SCHED __builtin_amdgcn_sched_barrier(0)
    Unit cur, nxt; int ui = 0;
    if (!S.next(0, cur)) return;
    f32x4 acc[2][2][4][2];
#pragma unroll
    for (int a = 0; a < 2; ++a)
#pragma unroll
        for (int b = 0; b < 2; ++b)
#pragma unroll
            for (int m = 0; m < 4; ++m)
#pragma unroll
                for (int n = 0; n < 2; ++n) acc[a][b][m][n] = (f32x4){0.f, 0.f, 0.f, 0.f};
    bf16x8 At[4][2], B0[2][2], B1[2][2];
    const char* cA = (const char*)g.A + (size_t)cur.pm * tstep; const char* cB = (const char*)g.Bt + (size_t)cur.pn * tstep;
    S.a_ready(cur);
    if constexpr (SP2) {
        PG8_STAGE(PG8_SB(0, 0), cB, voffB); PG8_STAGE(PG8_SB(0, 1), cB + hstep, voffB); PG8_STAGE(PG8_SA(0, 0), cA, voffA); PG8_STAGE(PG8_SA(0, 1), cA + hstep, voffA);
        if (wr == 1) PG8_BAR;
        PG8_WAIT_V(2); PG8_BAR;
        PG8_STAGE(PG8_SB(1, 0), cB + kstep, voffB); PG8_STAGE(PG8_SA(1, 0), cA + kstep, voffA); PG8_STAGE(PG8_SB(1, 1), cB + hstep + kstep, voffB);
        PG8_WAIT_V(6); PG8_BAR;
    } else {
        PG8_STAGE(PG8_SB(0, 0), cB, voffB); PG8_STAGE(PG8_SA(0, 0), cA, voffA); PG8_STAGE(PG8_SB(0, 1), cB + hstep, voffB); PG8_STAGE(PG8_SA(0, 1), cA + hstep, voffA);
        if (wr == 1) PG8_BAR;
        PG8_WAIT_V(4); PG8_BAR;
        PG8_STAGE(PG8_SB(1, 0), cB + kstep, voffB); PG8_STAGE(PG8_SA(1, 0), cA + kstep, voffA); PG8_STAGE(PG8_SB(1, 1), cB + hstep + kstep, voffB);
        PG8_WAIT_V(6); PG8_BAR;
    }
    for (;;) {
        const bool has_next = S.next(ui + 1, nxt);
        const char* nA = has_next ? (const char*)g.A + (size_t)nxt.pm * tstep : cA; const char* nB = has_next ? (const char*)g.Bt + (size_t)nxt.pn * tstep : cB;
        for (int t = 0; t < nt; t += 2) {
            const bool last = (t == nt - 2);
            const char* a1 = cA + (size_t)(t + 1) * kstep;
            const char* a2 = last ? nA : cA + (size_t)(t + 2) * kstep; const char* b2 = last ? nB : cB + (size_t)(t + 2) * kstep;
            const char* a3 = a2 + kstep; const char* b3 = b2 + kstep;
            if (last && has_next) S.a_ready(nxt);
            if constexpr (SP2) {
            PG8_LDB(B0, 0, 0); PG8_LDB(B1, 0, 1); PG8_SCHED; PG8_LDA(At, 0, 0); PG8_STAGE(PG8_SA(1, 1), a1 + hstep, voffA);
            PG8_WAIT_V(8); PG8_WAIT_L(0); PG8_BAR; PG8_MMA(0, 0, At, B0); PG8_MMA(0, 1, At, B1); PG8_BAR; PG8_SCHED;
            PG8_LDA(At, 0, 1); PG8_STAGE(PG8_SB(0, 0), b2, voffB); PG8_STAGE(PG8_SB(0, 1), b2 + hstep, voffB); PG8_STAGE(PG8_SA(0, 0), a2, voffA);
            PG8_WAIT_V(8); PG8_WAIT_L(0); PG8_BAR; PG8_MMA(1, 0, At, B0); PG8_MMA(1, 1, At, B1); PG8_BAR; PG8_SCHED;
            PG8_LDB(B0, 1, 0); PG8_LDB(B1, 1, 1); PG8_SCHED; PG8_LDA(At, 1, 0); PG8_STAGE(PG8_SA(0, 1), a2 + hstep, voffA);
            PG8_WAIT_V(8); PG8_WAIT_L(0); PG8_BAR; PG8_MMA(0, 0, At, B0); PG8_MMA(0, 1, At, B1); PG8_BAR; PG8_SCHED;
            PG8_LDA(At, 1, 1); PG8_STAGE(PG8_SB(1, 0), b3, voffB); PG8_STAGE(PG8_SB(1, 1), b3 + hstep, voffB); PG8_STAGE(PG8_SA(1, 0), a3, voffA);
            PG8_WAIT_V(8); PG8_WAIT_L(0); PG8_BAR; PG8_MMA(1, 0, At, B0); PG8_MMA(1, 1, At, B1); PG8_BAR; PG8_SCHED;
            } else {
            PG8_LDB(B0, 0, 0); PG8_SCHED; PG8_LDA(At, 0, 0); PG8_STAGE(PG8_SA(1, 1), a1 + hstep, voffA);
            PG8_WAIT_L(8); PG8_BAR; PG8_WAIT_L(0); PG8_MMA(0, 0, At, B0); PG8_BAR; PG8_SCHED;
            PG8_LDB(B1, 0, 1); PG8_STAGE(PG8_SB(0, 0), b2, voffB);
            PG8_BAR; PG8_WAIT_L(0); PG8_MMA(0, 1, At, B1); PG8_BAR;
            PG8_LDA(At, 0, 1); PG8_STAGE(PG8_SA(0, 0), a2, voffA);
            PG8_BAR; PG8_WAIT_L(0); PG8_MMA(1, 0, At, B0); PG8_BAR; PG8_SCHED;
            PG8_STAGE(PG8_SB(0, 1), b2 + hstep, voffB);
            PG8_WAIT_V(6); PG8_BAR; PG8_MMA(1, 1, At, B1); PG8_BAR;
            PG8_LDB(B0, 1, 0); PG8_SCHED; PG8_LDA(At, 1, 0); PG8_STAGE(PG8_SA(0, 1), a2 + hstep, voffA);
            PG8_WAIT_L(8); PG8_BAR; PG8_WAIT_L(0); PG8_MMA(0, 0, At, B0); PG8_BAR; PG8_SCHED;
            PG8_LDB(B1, 1, 1); PG8_STAGE(PG8_SB(1, 0), b3, voffB);
            PG8_BAR; PG8_WAIT_L(0); PG8_MMA(0, 1, At, B1); PG8_BAR;
            PG8_LDA(At, 1, 1); PG8_STAGE(PG8_SA(1, 0), a3, voffA);
            PG8_BAR; PG8_WAIT_L(0); PG8_MMA(1, 0, At, B0); PG8_BAR; PG8_SCHED;
            PG8_STAGE(PG8_SB(1, 1), b3 + hstep, voffB);
            PG8_WAIT_V(6); PG8_BAR; PG8_MMA(1, 1, At, B1); PG8_BAR;
            }
        }
        if constexpr (ALIGN_EPI) { if (wr == 0) PG8_BAR; }
        if constexpr (!Epi::AFTER_DRAIN) { E(acc, cur, wr, wc, fr, fq); S.done(cur); }
        if (!has_next) break;
#pragma unroll
        for (int a = 0; a < 2; ++a)
#pragma unroll
            for (int b = 0; b < 2; ++b)
#pragma unroll
                for (int m = 0; m < 4; ++m)
#pragma unroll
                    for (int n = 0; n < 2; ++n) acc[a][b][m][n] = (f32x4){0.f, 0.f, 0.f, 0.f};
        cur = nxt; cA = nA; cB = nB; ++ui;
        if constexpr (ALIGN_EPI) { if (wr == 1) PG8_BAR; }
    }
    PG8_WAIT_V(0);
    if constexpr (!ALIGN_EPI) { if (wr == 0) PG8_BAR; }
    PG8_BAR;
    if constexpr (Epi::AFTER_DRAIN) { E.fused(acc, cur, wr, wc, fr, fq, lds, wid, lane); S.done(cur); }
#undef PG8_SA
#undef PG8_SB
#undef PG8_STAGE
#undef PG8_LDA
#undef PG8_LDB
#undef PG8_MMA
#undef PG8_WAIT_V
#undef PG8_WAIT_L
#undef PG8_BAR
#undef PG8_SCHED
}
}

#define LAS __attribute__((address_space(3)))
#define GASP __attribute__((address_space(1)))
typedef unsigned short bf16;
typedef unsigned U4 __attribute__((ext_vector_type(4)));
typedef unsigned U2 __attribute__((ext_vector_type(2)));
typedef float F4 __attribute__((ext_vector_type(4)));
typedef float F16 __attribute__((ext_vector_type(16)));
typedef short H8 __attribute__((ext_vector_type(8)));
typedef short S4 __attribute__((ext_vector_type(4)));
typedef LAS const unsigned char* lds_cptr;

constexpr int D = 1024, T_P = 65536, T_S = 32768, T = T_P + T_S, FF = 2816, NQKV = 3072;
constexpr int S_P = 4096, S_S = 16384;
constexpr float LOG2E = 1.4426950408889634f;
constexpr float QSCALE = 0.125f * LOG2E;
constexpr float LAMBDA_INIT = 0.35550906759096926f;
constexpr float RMS_EPS = 1e-6f;
constexpr float NEGBIG = -1e30f;

constexpr size_t MiB = 1u << 20;
constexpr size_t WS_WQKV0 = 0, WS_WQKV1 = 6 * MiB, WS_WO0 = 12 * MiB, WS_WO1 = 14 * MiB, WS_WGU0 = 16 * MiB, WS_WGU1 = 27 * MiB, WS_WD0 = 38 * MiB, WS_WD1 = 44 * MiB;
constexpr size_t WS_CTL = 49 * MiB + 960 * 1024, CTL_BYTES = 16384;
constexpr size_t WS_RS = 49 * MiB + 512 * 1024;
static_assert(WS_RS + (size_t)T * 4 <= WS_CTL && WS_WD1 + (size_t)FF * D * 2 <= WS_RS, "rs array");
constexpr size_t WS_XN = 50 * MiB;
constexpr size_t WS_QO = 242 * MiB, WS_K = 434 * MiB, WS_V = 626 * MiB, WS_R = 818 * MiB, WS_END = 1010 * MiB;
constexpr size_t WS_O = WS_XN;
constexpr size_t WS_ACT = WS_QO;
static_assert(WS_ACT + (size_t)T * FF * 2 <= WS_R, "act overlay");
#ifndef REP_NA
#define REP_NA 1
#endif
#ifndef REP_DA
#define REP_DA 1
#endif
#ifndef REP_GEMM
#define REP_GEMM 1
#endif

constexpr int LDS_BYTES = 155648;
constexpr int NWAVES = 8;

__device__ __forceinline__ int crow(int r, int hi) { return (r & 3) + 8 * (r >> 2) + 4 * hi; }
typedef float f32x2_t __attribute__((ext_vector_type(2))); typedef __bf16 bf16x2_t __attribute__((ext_vector_type(2)));
__device__ __forceinline__ unsigned cvtpk(float lo, float hi) { f32x2_t v = {lo, hi}; bf16x2_t b = __builtin_convertvector(v, bf16x2_t); return __builtin_bit_cast(unsigned, b); }
typedef short v4i16_t __attribute__((ext_vector_type(4)));
__device__ __forceinline__ S4 vtr(lds_cptr p) { return __builtin_bit_cast(S4, __builtin_amdgcn_ds_read_tr16_b64_v4i16((LAS v4i16_t*)p)); }
__device__ __forceinline__ float wave_sum(float v) {
#pragma unroll
    for (int o = 1; o < 64; o <<= 1) v += __shfl_xor(v, o);
    return v;
}
__device__ __forceinline__ float half_swap_max(float v) { auto rr = __builtin_amdgcn_permlane32_swap(__float_as_uint(v), __float_as_uint(v), false, false); return fmaxf(__uint_as_float(rr[0]), __uint_as_float(rr[1])); }
__device__ __forceinline__ float half_swap_sum(float v) { auto rr = __builtin_amdgcn_permlane32_swap(__float_as_uint(v), __float_as_uint(v), false, false); return __uint_as_float(rr[0]) + __uint_as_float(rr[1]); }

#define DS_RD128(dst, addr, off) asm volatile("ds_read_b128 %0, %1 offset:%c2" : "=v"(dst) : "v"(addr), "i"(off) : "memory")
#define DS_RDTR(dst, addr, off) asm volatile("ds_read_b64_tr_b16 %0, %1 offset:%c2" : "=v"(dst) : "v"(addr), "i"(off) : "memory")
#define LGKM_WAIT(n) asm volatile("s_waitcnt lgkmcnt(" #n ")" ::: "memory")
#define SCHED_FENCE() __builtin_amdgcn_sched_barrier(0)
template <int NDB>
__device__ __forceinline__ void flash_step(F16& p0, F16& p1, float& m, float& l, F16 (&o)[NDB], LAS float* wsf, lds_cptr vp, int r32, int hi) {
    float a0 = __builtin_fmaxf(__builtin_fmaxf(p0[0], p0[1]), p0[2]), a1 = __builtin_fmaxf(__builtin_fmaxf(p1[0], p1[1]), p1[2]);
#pragma unroll
    for (int r = 3; r < 15; r += 2) { a0 = __builtin_fmaxf(__builtin_fmaxf(a0, p0[r]), p0[r + 1]); a1 = __builtin_fmaxf(__builtin_fmaxf(a1, p1[r]), p1[r + 1]); }
    const float al = __builtin_fmaxf(__builtin_fmaxf(a0, p0[15]), __builtin_fmaxf(a1, p1[15]));
    if (__any(al > m + 8.0f)) {
        const float rm = half_swap_max(al);
        const float mn = fmaxf(m, rm); const float f = __builtin_amdgcn_exp2f(m - mn); l *= f; m = mn;
        if (hi == 0) wsf[r32] = f;
#pragma unroll
        for (int r = 0; r < 16; ++r) { const float fr = wsf[crow(r, hi)];
#pragma unroll
            for (int db = 0; db < NDB; ++db) o[db][r] *= fr; }
    }
    float s = 0.f;
#pragma unroll
    for (int r = 0; r < 16; ++r) { p0[r] = __builtin_amdgcn_exp2f(p0[r] - m); p1[r] = __builtin_amdgcn_exp2f(p1[r] - m); s += p0[r] + p1[r]; }
    l += s;
    U4 pw[4];
#pragma unroll
    for (int k = 0; k < 2; ++k) {
        pw[k]     = (U4){cvtpk(p0[8 * k], p0[8 * k + 1]), cvtpk(p0[8 * k + 2], p0[8 * k + 3]), cvtpk(p0[8 * k + 4], p0[8 * k + 5]), cvtpk(p0[8 * k + 6], p0[8 * k + 7])};
        pw[2 + k] = (U4){cvtpk(p1[8 * k], p1[8 * k + 1]), cvtpk(p1[8 * k + 2], p1[8 * k + 3]), cvtpk(p1[8 * k + 4], p1[8 * k + 5]), cvtpk(p1[8 * k + 6], p1[8 * k + 7])};
    }
    const unsigned vaddr = (unsigned)(uintptr_t)vp;
    S4 va[8];
    static_assert(NDB == 2, "flash_step: two 32-column blocks");
#pragma unroll
    for (int db = 0; db < 2; ++db) {
#pragma unroll
        for (int k = 0; k < 4; ++k) { DS_RDTR(va[2 * k], vaddr, db * 4096 + k * 1024); DS_RDTR(va[2 * k + 1], vaddr, db * 4096 + k * 1024 + 512); }
        LGKM_WAIT(0); SCHED_FENCE();
#pragma unroll
        for (int k = 0; k < 4; ++k) { const H8 vf = (H8){va[2 * k][0], va[2 * k][1], va[2 * k][2], va[2 * k][3], va[2 * k + 1][0], va[2 * k + 1][1], va[2 * k + 1][2], va[2 * k + 1][3]};
            o[db] = __builtin_amdgcn_mfma_f32_32x32x16_bf16(__builtin_bit_cast(H8, pw[k]), vf, o[db], 0, 0, 0); }
        SCHED_FENCE();
    }
}

template <int MODE  , bool NQ>
__device__ __forceinline__ void tr_item(const float* W, int K, int N, bf16* WT, LAS float* scr, int item, int lane, const float* ks, int kmask, float kmul) {
    const int nblk = N / 32, kb = item / nblk, nb = item % nblk, k0 = 64 * kb, n0 = 32 * nb;
    const float nm = (NQ && n0 < 1024) ? QSCALE : 1.f;
#pragma unroll 8
    for (int i = 0; i < 32; ++i) { const int kk = 2 * i + (lane >> 5); float sc = nm; if (ks) sc *= ((const GASP float*)ks)[(k0 + kk) & kmask] * kmul;
        scr[kk * 33 + (lane & 31)] = ((const GASP float*)W)[(size_t)(k0 + kk) * N + n0 + (lane & 31)] * sc; }
    const int c = lane & 7;
#pragma unroll
    for (int j = 0; j < 4; ++j) { const int n = (lane >> 3) + 8 * j; const LAS float* s = scr + (8 * c) * 33 + n;
        U4 o; o.x = cvtpk(s[0 * 33], s[1 * 33]); o.y = cvtpk(s[2 * 33], s[3 * 33]); o.z = cvtpk(s[4 * 33], s[5 * 33]); o.w = cvtpk(s[6 * 33], s[7 * 33]);
        const int nn = n0 + n; const int row = (MODE == 0) ? nn : ((nn >> 7) * 256 + (MODE == 2 ? 128 : 0) + (nn & 127));
        *(GASP U4*)(WT + (size_t)row * K + k0 + 8 * c) = o; }
}

__device__ __forceinline__ void row_to_bf16_rs(const float* xrow, bf16* orow, float* rs, int lane) {
    const GASP F4* xr = (const GASP F4*)xrow + lane;
    F4 v[4]; float s = 0.f;
#pragma unroll
    for (int j = 0; j < 4; ++j) { v[j] = xr[64 * j]; s += (v[j].x * v[j].x + v[j].y * v[j].y) + (v[j].z * v[j].z + v[j].w * v[j].w); }
    const float rstd = rsqrtf(wave_sum(s) * (1.f / D) + RMS_EPS);
    GASP U2* o8 = (GASP U2*)orow + lane;
#pragma unroll
    for (int j = 0; j < 4; ++j) o8[64 * j] = (U2){cvtpk(v[j].x, v[j].y), cvtpk(v[j].z, v[j].w)};
    if (lane == 0) *(GASP float*)rs = rstd;
}

__device__ __forceinline__ F4 bf4(U2 w) { return (F4){__uint_as_float(w.x << 16), __uint_as_float(w.x & 0xffff0000u), __uint_as_float(w.y << 16), __uint_as_float(w.y & 0xffff0000u)}; }
template <bool OUT_F32>
__device__ __forceinline__ void resid_rows2(const bf16* M, bf16* R, float* out, float* RS, const float* g, int m0, int m1, int lane) {
    const int mm[2] = {m0, m1};
    F4 mv[2][4], xv[2][4];
#pragma unroll
    for (int q = 0; q < 2; ++q) { const int m = mm[q]; const GASP U2* mr = (const GASP U2*)(M + (size_t)m * D) + lane; const GASP U2* rr = (const GASP U2*)(R + (size_t)m * D) + lane;
#pragma unroll
        for (int j = 0; j < 4; ++j) { mv[q][j] = bf4(mr[64 * j]); xv[q][j] = bf4(rr[64 * j]); } }
    const GASP F4* gr = (const GASP F4*)g + lane;
#pragma unroll
    for (int q = 0; q < 2; ++q) { const int m = mm[q]; float s = 0.f;
#pragma unroll
        for (int j = 0; j < 4; ++j) s += (mv[q][j].x * mv[q][j].x + mv[q][j].y * mv[q][j].y) + (mv[q][j].z * mv[q][j].z + mv[q][j].w * mv[q][j].w);
        const float rstd = rsqrtf(wave_sum(s) * (1.f / D) + RMS_EPS); float s2 = 0.f;
#pragma unroll
        for (int j = 0; j < 4; ++j) { const F4 gv = gr[64 * j]; xv[q][j] = xv[q][j] + mv[q][j] * rstd * gv; s2 += (xv[q][j].x * xv[q][j].x + xv[q][j].y * xv[q][j].y) + (xv[q][j].z * xv[q][j].z + xv[q][j].w * xv[q][j].w); }
        if (OUT_F32) { GASP F4* orow = (GASP F4*)(out + (size_t)m * D) + lane;
#pragma unroll
            for (int j = 0; j < 4; ++j) orow[64 * j] = xv[q][j]; }
        else { GASP U2* rw = (GASP U2*)(R + (size_t)m * D) + lane;
#pragma unroll
            for (int j = 0; j < 4; ++j) rw[64 * j] = (U2){cvtpk(xv[q][j].x, xv[q][j].y), cvtpk(xv[q][j].z, xv[q][j].w)};
            const float r2 = rsqrtf(wave_sum(s2) * (1.f / D) + RMS_EPS); if (lane == 0) ((GASP float*)RS)[m] = r2; } }
}

__device__ __forceinline__ void na_phase(LAS unsigned char* lds, const bf16* Q, const bf16* Kb, const bf16* Vb, bf16* O, const float* rpb, int G, int wave, int lane) {
    const int r32 = lane & 31, hi = lane >> 5;
    LAS unsigned char* vbuf = lds + wave * 16384;
    LAS float* rpbL = (LAS float*)(lds + 131072 + wave * 2048);
    LAS float* wsf = (LAS float*)(lds + 147456 + wave * 128);
    LAS bf16* ost = (LAS bf16*)vbuf;
    const lds_cptr vp = (lds_cptr)vbuf + ((lane >> 4) & 1) * 32 + (lane & 3) * 8 + (4 * hi + ((lane & 15) >> 2)) * 64;
    const int blk = blockIdx.x;
    int x, c, ncx, nX; if (G % 8 == 0) { x = blk % 8; c = blk / 8; ncx = G / 8; nX = 8; } else { x = 0; c = blk; ncx = G; nX = 1; }
    const int per = 3072 / nX;
    int cur_h = -1;
    for (int li = c; li < per; li += ncx) {
        const int U = x * per + li, R = U >> 1, h = 8 * (U & 1) + wave;
        if (h != cur_h) { for (int i = lane; i < 465; i += 64) rpbL[i] = ((const GASP float*)rpb)[h * 465 + i] * LOG2E; cur_h = h; }
        int r, nrows; if (R < 1024) { r = R & 63; nrows = 64; } else { r = (R - 1024) & 255; nrows = 256; }
        const int Rbase = R - r; const int row0 = min(max(r - 4, 0), nrows - 8);
        {
            H8 qfa[4], qfb[4];
#pragma unroll
            for (int d0 = 0; d0 < 4; ++d0) { qfa[d0] = *(const GASP H8*)(Q + ((size_t)h * T + (size_t)R * 64 + r32) * 64 + 16 * d0 + 8 * hi); qfb[d0] = *(const GASP H8*)(Q + ((size_t)h * T + (size_t)R * 64 + 32 + r32) * 64 + 16 * d0 + 8 * hi); }
            float ma = NEGBIG, mb = NEGBIG, la = 0.f, lb = 0.f; F16 oa[2], ob[2]; oa[0] = F16{}; oa[1] = F16{}; ob[0] = F16{}; ob[1] = F16{};
            H8 kn[8];
            const char* kub = (const char*)Kb + ((size_t)h * T + (size_t)(Rbase + row0) * 64) * 128;
            const char* vub = (const char*)Vb + ((size_t)h * T + (size_t)(Rbase + row0) * 64) * 128;
            const unsigned kofs = (unsigned)((r32 * 64 + 8 * hi) * 2);
            const unsigned vofs = (unsigned)(((lane >> 2) * 64 + (lane & 3) * 8) * 2);
#define NA_KLOAD() do { _Pragma("unroll") for (int d0 = 0; d0 < 4; ++d0) { kn[2 * d0] = *(const GASP H8*)(kub + kofs + 32 * d0); kn[2 * d0 + 1] = *(const GASP H8*)(kub + kofs + 32 * 128 + 32 * d0); } } while (0)
#define NA_VDMA(buf) do { _Pragma("unroll") for (int i_ = 0; i_ < 8; ++i_) \
        __builtin_amdgcn_global_load_lds((const unsigned*)(vub + vofs + (16 * (i_ & 3)) * 128 + (i_ >> 2) * 64), (LAS unsigned*)(vbuf + (buf) * 8192 + i_ * 1024), 16, 0, 0); } while (0)
#define NA_SCORES(QF, QB, P0, P1) do { P0 = F16{}; P1 = F16{}; \
        _Pragma("unroll") for (int d0 = 0; d0 < 4; ++d0) { P0 = __builtin_amdgcn_mfma_f32_32x32x16_bf16(kn[2 * d0], QF[d0], P0, 0, 0, 0); P1 = __builtin_amdgcn_mfma_f32_32x32x16_bf16(kn[2 * d0 + 1], QF[d0], P1, 0, 0, 0); } \
        const int qc_ = 32 * (QB) + r32, qs_ = min(max(qc_ - 8, 0), 48); \
        int uu = 4 * hi - qs_, uu2 = 4 * hi - qc_ + 15; asm volatile("" : "+v"(uu), "+v"(uu2)); \
        const LAS float* brow = rpbL + dr * 31 + uu2; \
        _Pragma("unroll") for (int g4 = 0; g4 < 4; ++g4) { float b0_[4], b1_[4]; \
            _Pragma("unroll") for (int e = 0; e < 4; ++e) { b0_[e] = brow[8 * g4 + e]; b1_[e] = brow[8 * g4 + e + 32]; } \
            _Pragma("unroll") for (int e = 0; e < 4; ++e) asm volatile("" : "+v"(b0_[e]), "+v"(b1_[e]));     \
            _Pragma("unroll") for (int e = 0; e < 4; ++e) { const int rr = 4 * g4 + e, kcst = 8 * g4 + e; \
                const bool v0 = (unsigned)(uu + kcst) < 16u, v1 = (unsigned)(uu + kcst + 32) < 16u; \
                const float s0 = P0[rr] + b0_[e], s1 = P1[rr] + b1_[e]; \
                P0[rr] = v0 ? s0 : NEGBIG; P1[rr] = v1 ? s1 : NEGBIG; } } } while (0)
#define NA_STORE(OO, LL, QB) do { int le_ = lane; asm volatile("" : "+v"(le_)); const int r32e = le_ & 31, hie = le_ >> 5;     \
        const float lt = half_swap_sum(LL); if (hie == 0) wsf[r32e] = 1.0f / lt; \
        _Pragma("unroll") for (int rr = 0; rr < 16; ++rr) { const float f = wsf[crow(rr, hie)]; const int orow = crow(rr, hie); \
            _Pragma("unroll") for (int db = 0; db < 2; ++db) { const unsigned w = cvtpk(OO[db][rr] * f, 0.f); ost[orow * 64 + db * 32 + r32e] = (bf16)(w & 0xffffu); } } \
        _Pragma("unroll") for (int i = 0; i < 4; ++i) { const int row = i * 8 + (le_ >> 3), ch = le_ & 7; const U4 v = *(const LAS U4*)(ost + row * 64 + ch * 8); \
            *(GASP U4*)(O + ((size_t)R * 64 + 32 * (QB) + row) * D + h * 64 + ch * 8) = v; } } while (0)
            NA_VDMA(0);
            NA_KLOAD();
#pragma unroll 1
            for (int kr = 0; kr < 8; ++kr) {
                asm volatile("s_waitcnt vmcnt(0)" ::: "memory");
                const int dr = row0 + kr - r + 7;
                {   F16 p0, p1; NA_SCORES(qfa, 0, p0, p1);
                    flash_step<2>(p0, p1, ma, la, oa, wsf, vp + (kr & 1) * 8192, r32, hi); }
                {   F16 p0, p1; NA_SCORES(qfb, 1, p0, p1);
                    if (kr < 7) { kub += 64 * 128; vub += 64 * 128;
                        if (kr & 1) NA_VDMA(0); else NA_VDMA(1);
                        NA_KLOAD(); }
                    flash_step<2>(p0, p1, mb, lb, ob, wsf, vp + (kr & 1) * 8192, r32, hi); }
            }
            NA_STORE(oa, la, 0);
            NA_STORE(ob, lb, 1);
#undef NA_VDMA
#undef NA_KLOAD
#undef NA_SCORES
#undef NA_STORE
        }
    }
}

__device__ __forceinline__ int t5_bucket(int rel) { const int n = rel < 0 ? -rel : rel; const int big = min(15, 2 + (31 - __clz(n * n | 1))); return (rel > 0 ? 16 : 0) + (n < 8 ? n : big); }
typedef float F2 __attribute__((ext_vector_type(2)));
#define DA_VREADS(v, vaddr, DB) do { _Pragma("unroll") for (int k_ = 0; k_ < 4; ++k_) { DS_RDTR(v[2 * k_], vaddr, (DB) * 4096 + k_ * 1024); DS_RDTR(v[2 * k_ + 1], vaddr, (DB) * 4096 + k_ * 1024 + 512); } } while (0)
#define DA_VMFMA(v, DB) do { _Pragma("unroll") for (int k_ = 0; k_ < 4; ++k_) { const H8 vf_ = (H8){v[2 * k_][0], v[2 * k_][1], v[2 * k_][2], v[2 * k_][3], v[2 * k_ + 1][0], v[2 * k_ + 1][1], v[2 * k_ + 1][2], v[2 * k_ + 1][3]}; \
        o[DB] = __builtin_amdgcn_mfma_f32_32x32x16_bf16(__builtin_bit_cast(H8, pw[k_]), vf_, o[DB], 0, 0, 0); } } while (0)
__device__ __forceinline__ void da_pv(F16 (&o)[4], const U4 (&pw)[4], S4 (&va)[8], S4 (&vb)[8], unsigned vaddr) {
    LGKM_WAIT(0); SCHED_FENCE(); DA_VMFMA(va, 0); SCHED_FENCE();
    DA_VREADS(va, vaddr, 2); SCHED_FENCE(); DA_VMFMA(vb, 1); SCHED_FENCE();
    DA_VREADS(vb, vaddr, 3); LGKM_WAIT(8); SCHED_FENCE(); DA_VMFMA(va, 2); SCHED_FENCE();
    LGKM_WAIT(0); SCHED_FENCE(); DA_VMFMA(vb, 3); SCHED_FENCE();
}
#define DA_ILV() do { _Pragma("unroll") for (int g_ = 0; g_ < 4; ++g_) { __builtin_amdgcn_sched_group_barrier(0x008, 1, 0); __builtin_amdgcn_sched_group_barrier(0x002, 4, 0); } } while (0)
#define DA_EXP8(P, B, acc) do { _Pragma("unroll") for (int r_ = 0; r_ < 8; ++r_) { P[(B) + r_] = __builtin_amdgcn_exp2f(P[(B) + r_]); acc += P[(B) + r_]; } } while (0)
__device__ __forceinline__ float fadd_s(float a, float b) { float r; asm("v_add_f32_e32 %0, %1, %2" : "=v"(r) : "v"(a), "v"(b)); return r; }
#define DA_GAP(v, DB, K_, P, B, acc) do { const H8 vf_ = (H8){v[2 * (K_)][0], v[2 * (K_)][1], v[2 * (K_)][2], v[2 * (K_)][3], v[2 * (K_) + 1][0], v[2 * (K_) + 1][1], v[2 * (K_) + 1][2], v[2 * (K_) + 1][3]}; \
        o[DB] = __builtin_amdgcn_mfma_f32_32x32x16_bf16(__builtin_bit_cast(H8, pw[K_]), vf_, o[DB], 0, 0, 0); \
        P[(B)] = __builtin_amdgcn_exp2f(P[(B)]); P[(B) + 1] = __builtin_amdgcn_exp2f(P[(B) + 1]); acc += P[(B)]; acc += P[(B) + 1]; SCHED_FENCE(); } while (0)
#define DA_GROUP(v, DB, P, B, acc) do { DA_GAP(v, DB, 0, P, (B), acc); DA_GAP(v, DB, 1, P, (B) + 2, acc); DA_GAP(v, DB, 2, P, (B) + 4, acc); DA_GAP(v, DB, 3, P, (B) + 6, acc); } while (0)
#define DA_PACK8(P, B) (U4){cvtpk(P[(B)], P[(B) + 1]), cvtpk(P[(B) + 2], P[(B) + 3]), cvtpk(P[(B) + 4], P[(B) + 5]), cvtpk(P[(B) + 6], P[(B) + 7])}
__device__ __forceinline__ void da_phase(LAS unsigned char* lds, const bf16* Q, const bf16* Kb, const bf16* Vb, bf16* O, const float* lq1, const float* lk1, const float* lq2, const float* lk2,
                                         const float* t5, int G, int wave, int lane, int tid) {
    const int r32 = lane & 31, hi = lane >> 5, comp = wave >> 2, w4 = wave & 3;
    constexpr int KS = 0, VS = 49152;
    LAS bf16* ost = (LAS bf16*)(lds + 114688 + w4 * 8192);
    LAS float* lut = (LAS float*)(lds + 147456);
    LAS float* wsf = (LAS float*)(lds + 149504 + wave * 128);
    const float lam = __builtin_expf(wave_sum(lq1[lane] * lk1[lane])) - __builtin_expf(wave_sum(lq2[lane] * lk2[lane])) + LAMBDA_INIT;
    const int blk = blockIdx.x;
    int x, c, ncx, nX; if (G % 8 == 0) { x = blk % 8; c = blk / 8; ncx = G / 8; nX = 8; } else { x = 0; c = blk; ncx = G; nX = 1; }
    const int perP = 4096 / nX, perS = 2048 / nX, per = perP + perS;
    const int vlane = ((lane >> 4) & 1) * 32 + (lane & 3) * 8 + (4 * hi + ((lane & 15) >> 2)) * 64;
    const unsigned ldsb = (unsigned)(uintptr_t)lds;
    int cur_h = -1;
    for (int li = c; li < per; li += ncx) {
        int b, h, qb, S; size_t tok0;
        if (li < perP) { const int gi = x * perP + li; const int pair = gi >> 5; qb = gi & 31; b = pair >> 3; h = pair & 7; S = S_P; tok0 = (size_t)b * S_P; }
        else { const int gi = x * perS + (li - perP); const int pair = gi >> 7; qb = gi & 127; b = pair >> 3; h = pair & 7; S = S_S; tok0 = (size_t)T_P + (size_t)b * S_S; }
        if (h != cur_h) { __syncthreads(); for (int i = tid; i < 257; i += 512) lut[i] = ((const GASP float*)t5)[t5_bucket(i - 128) * 8 + h] * LOG2E; __syncthreads(); cur_h = h; }
        const int qrow0 = qb * 128 + 32 * w4;
        H8 qf[4];
#pragma unroll
        for (int d0 = 0; d0 < 4; ++d0) qf[d0] = *(const GASP H8*)(Q + ((size_t)h * T + tok0 + qrow0 + r32) * 128 + comp * 64 + 16 * d0 + 8 * hi);
        float m = 0.f, l = 0.f; F16 o[4];
#pragma unroll
        for (int db = 0; db < 4; ++db) o[db] = F16{};
        int cur_cls = -1; float cb = 0.f, cbm = 0.f;
        U4 pw[4] = {};
        const int NT = S / 64;
        const char* kub = (const char*)Kb + (((size_t)h * T + tok0 + 32 * (wave & 1)) * 128 + (wave >> 2) * 64 + ((wave >> 1) & 1) * 32) * 2;
        const char* vub = (const char*)Vb + (((size_t)h * T + tok0 + 16 * ((2 * wave) & 3)) * 128 + ((2 * wave) >> 2) * 32) * 2;
        const unsigned kofs = (unsigned)(((lane >> 2) * 128 + ((lane & 3) ^ ((lane >> 4) & 3)) * 8) * 2);
        const unsigned vofs = (unsigned)(((lane >> 2) * 128 + (lane & 3) * 8) * 2);
#define DA_DMA_K(tt, kslot) do { const char* kb_ = kub + (size_t)(tt) * (64 * 128 * 2); \
        __builtin_amdgcn_global_load_lds((const unsigned*)(kb_ + kofs), (LAS unsigned*)(lds + KS + (kslot) * 16384 + (2 * wave) * 1024), 16, 0, 0); \
        __builtin_amdgcn_global_load_lds((const unsigned*)(kb_ + 16 * 128 * 2 + kofs), (LAS unsigned*)(lds + KS + (kslot) * 16384 + (2 * wave + 1) * 1024), 16, 0, 0); } while (0)
#define DA_DMA_V(tt, vslot) do { const char* vb_ = vub + (size_t)(tt) * (64 * 128 * 2); \
        __builtin_amdgcn_global_load_lds((const unsigned*)(vb_ + vofs), (LAS unsigned*)(lds + VS + (vslot) * 16384 + (2 * wave) * 1024), 16, 0, 0); \
        __builtin_amdgcn_global_load_lds((const unsigned*)(vb_ + 16 * 128 * 2 + vofs), (LAS unsigned*)(lds + VS + (vslot) * 16384 + (2 * wave + 1) * 1024), 16, 0, 0); } while (0)
#define DA_DMA(tt, kslot, vslot) do { DA_DMA_K(tt, kslot); DA_DMA_V(tt, vslot); } while (0)
        DA_DMA(0, 0, 0); DA_DMA(1, 1, 1);
        int ks_cur = 0, ks_n2 = 2;
        const unsigned kswz = (unsigned)((hi ^ ((r32 >> 2) & 3)) * 16);
        const unsigned ka_base = ldsb + KS + comp * 8192 + r32 * 64;
        S4 va[8], vb[8];
#pragma unroll 1
        for (int t = 0; t < NT; ++t) {
            if (t + 1 < NT) asm volatile("s_waitcnt vmcnt(4)" ::: "memory"); else asm volatile("s_waitcnt vmcnt(0)" ::: "memory");
            __builtin_amdgcn_s_barrier();
            asm volatile("" ::: "memory");
            const unsigned vaddr_p = ldsb + VS + ((t == 0 ? 0 : t + 3) & 3) * 16384 + vlane;
            U4 kf[4];
            const unsigned ka0 = ka_base + ks_cur * 16384 + kswz, ka1 = ka_base + ks_cur * 16384 + (kswz ^ 32u);
            DS_RD128(kf[0], ka0, 0); DS_RD128(kf[1], ka1, 0); DS_RD128(kf[2], ka0, 4096); DS_RD128(kf[3], ka1, 4096);
            DA_VREADS(va, vaddr_p, 0); DA_VREADS(vb, vaddr_p, 1);
            const int kv0 = 64 * t; const int relmin = kv0 - (qrow0 + 31), relmax = kv0 + 63 - qrow0;
            const int cls = 1 + (relmin >= 128 ? 1 : 0) - (relmax <= -128 ? 1 : 0);
            if (cls != cur_cls) { cur_cls = cls; cb = (cls == 2) ? lut[256] : ((cls == 0) ? lut[0] : 0.f); cbm = cb - m; }
            F16 p0, p1;
            {   typedef float F2i __attribute__((ext_vector_type(2))); F2i c2 = {cbm, cbm}; asm volatile("" : "+v"(c2));
#pragma unroll
                for (int r = 0; r < 16; r += 2) { p0[r] = c2.x; p0[r + 1] = c2.y; p1[r] = c2.x; p1[r + 1] = c2.y; } }
            asm volatile("s_waitcnt lgkmcnt(15)" ::: "memory"); SCHED_FENCE();
#pragma unroll
            for (int d0 = 0; d0 < 4; ++d0) p0 = __builtin_amdgcn_mfma_f32_32x32x16_bf16(__builtin_bit_cast(H8, kf[d0]), qf[d0], p0, 0, 0, 0);
            SCHED_FENCE();
            DS_RD128(kf[0], ka0, 2048); DS_RD128(kf[1], ka1, 2048); DS_RD128(kf[2], ka0, 6144); DS_RD128(kf[3], ka1, 6144);
            if (t + 2 < NT) DA_DMA_K(t + 2, ks_n2);
            LGKM_WAIT(0); SCHED_FENCE();
            float a0;
            p1 = __builtin_amdgcn_mfma_f32_32x32x16_bf16(__builtin_bit_cast(H8, kf[0]), qf[0], p1, 0, 0, 0); a0 = __builtin_fmaxf(__builtin_fmaxf(p0[0], p0[1]), p0[2]); a0 = __builtin_fmaxf(__builtin_fmaxf(a0, p0[3]), p0[4]); asm volatile("" : "+v"(a0)); SCHED_FENCE();
            p1 = __builtin_amdgcn_mfma_f32_32x32x16_bf16(__builtin_bit_cast(H8, kf[1]), qf[1], p1, 0, 0, 0); a0 = __builtin_fmaxf(__builtin_fmaxf(a0, p0[5]), p0[6]); a0 = __builtin_fmaxf(__builtin_fmaxf(a0, p0[7]), p0[8]); asm volatile("" : "+v"(a0)); SCHED_FENCE();
            p1 = __builtin_amdgcn_mfma_f32_32x32x16_bf16(__builtin_bit_cast(H8, kf[2]), qf[2], p1, 0, 0, 0); a0 = __builtin_fmaxf(__builtin_fmaxf(a0, p0[9]), p0[10]); a0 = __builtin_fmaxf(__builtin_fmaxf(a0, p0[11]), p0[12]); asm volatile("" : "+v"(a0)); SCHED_FENCE();
            p1 = __builtin_amdgcn_mfma_f32_32x32x16_bf16(__builtin_bit_cast(H8, kf[3]), qf[3], p1, 0, 0, 0); a0 = __builtin_fmaxf(__builtin_fmaxf(a0, p0[13]), p0[14]); a0 = __builtin_fmaxf(a0, p0[15]); asm volatile("" : "+v"(a0)); SCHED_FENCE();
            if (t + 2 < NT) DA_DMA_V(t + 2, (t + 2) & 3);
            if (cls == 1) { const int base = kv0 - (qrow0 + r32) + 128;
#pragma unroll
                for (int r = 0; r < 16; ++r) { const int i0 = base + crow(r, hi), i1 = i0 + 32;
                    p0[r] += lut[min(max(i0, 0), 256)]; p1[r] += lut[min(max(i1, 0), 256)];
                    if ((r & 1) == 1) asm volatile("" ::: "memory"); }
                a0 = __builtin_fmaxf(__builtin_fmaxf(p0[0], p0[1]), p0[2]);
#pragma unroll
                for (int r = 3; r < 15; r += 2) a0 = __builtin_fmaxf(__builtin_fmaxf(a0, p0[r]), p0[r + 1]);
                a0 = __builtin_fmaxf(a0, p0[15]); }
            float a1 = __builtin_fmaxf(__builtin_fmaxf(p1[0], p1[1]), p1[2]);
#pragma unroll
            for (int r = 3; r < 15; r += 2) a1 = __builtin_fmaxf(__builtin_fmaxf(a1, p1[r]), p1[r + 1]);
            a1 = __builtin_fmaxf(a1, p1[15]);
            const float rml = __builtin_fmaxf(a0, a1);
            if (t == 0 || __any(rml > 8.0f)) {
                const float rm = half_swap_max(rml);
                const float dl = (t == 0) ? rm : __builtin_fmaxf(rm, 0.f); m += dl;
#pragma unroll
                for (int r = 0; r < 16; ++r) { p0[r] -= dl; p1[r] -= dl; }
                cbm = cb - m;
                const float f = __builtin_amdgcn_exp2f(-dl); l *= f;
#pragma unroll
                for (int k = 0; k < 4; ++k)
#pragma unroll
                    for (int e = 0; e < 4; ++e) { const unsigned w = pw[k][e]; pw[k][e] = cvtpk(__uint_as_float(w << 16) * f, __uint_as_float(w & 0xffff0000u) * f); }
                if (hi == 0) wsf[r32] = f;
#pragma unroll
                for (int r = 0; r < 16; ++r) { const float fr = wsf[crow(r, hi)];
#pragma unroll
                    for (int db = 0; db < 4; ++db) o[db][r] *= fr; }
            }
            float sa = 0.f, sb = 0.f;
            SCHED_FENCE(); DA_GROUP(va, 0, p0, 0, sa);
            DA_VREADS(va, vaddr_p, 2); SCHED_FENCE();
            DA_GROUP(vb, 1, p0, 8, sa);
            DA_VREADS(vb, vaddr_p, 3); LGKM_WAIT(8); SCHED_FENCE();
            DA_GROUP(va, 2, p1, 0, sa);
            LGKM_WAIT(0); SCHED_FENCE();
            DA_GROUP(vb, 3, p1, 8, sa);
            l += sa + sb;
            pw[0] = DA_PACK8(p0, 0); pw[1] = DA_PACK8(p0, 8); pw[2] = DA_PACK8(p1, 0); pw[3] = DA_PACK8(p1, 8);
            ks_cur = (ks_cur == 2) ? 0 : ks_cur + 1; ks_n2 = (ks_n2 == 2) ? 0 : ks_n2 + 1;
        }
        {   const unsigned vaddr = ldsb + VS + ((NT - 1) & 3) * 16384 + vlane; DA_VREADS(va, vaddr, 0); DA_VREADS(vb, vaddr, 1); da_pv(o, pw, va, vb, vaddr); }
#undef DA_DMA
#undef DA_DMA_K
#undef DA_DMA_V
        int lane_e = lane; asm volatile("" : "+v"(lane_e));
        const int r32e = lane_e & 31, hie = lane_e >> 5;
        const float lt = half_swap_sum(l);
        if (hie == 0) wsf[r32e] = (comp == 0 ? 1.0f : -lam) / lt;
#pragma unroll
        for (int r = 0; r < 16; ++r) { const float f = wsf[crow(r, hie)];
#pragma unroll
            for (int db = 0; db < 4; ++db) o[db][r] *= f; }
        __syncthreads();
        LAS float* xb = (LAS float*)lds + w4 * 4096;
        if (comp == 1) {
#pragma unroll
            for (int db = 0; db < 4; ++db)
#pragma unroll
                for (int r = 0; r < 16; ++r) xb[(db * 16 + r) * 64 + lane_e] = o[db][r];
        }
        __syncthreads();
        if (comp == 0) {
            float ss[16];
#pragma unroll
            for (int r = 0; r < 16; ++r) { float q = 0.f;
#pragma unroll
                for (int db = 0; db < 4; ++db) { o[db][r] += xb[(db * 16 + r) * 64 + lane_e]; q += o[db][r] * o[db][r]; }
                ss[r] = q; }
#pragma unroll
            for (int r = 0; r < 16; ++r) {
#pragma unroll
                for (int off = 1; off < 32; off <<= 1) ss[r] += __shfl_xor(ss[r], off);
                const float rs = rsqrtf(ss[r] * (1.0f / 128.0f) + RMS_EPS); const int orow = crow(r, hie);
#pragma unroll
                for (int db = 0; db < 4; ++db) { const unsigned w = cvtpk(o[db][r] * rs, 0.f); ost[orow * 128 + db * 32 + r32e] = (bf16)(w & 0xffffu); } }
#pragma unroll
            for (int i = 0; i < 8; ++i) { const int row = i * 4 + (lane_e >> 4), ch = lane_e & 15; const U4 v = *(const LAS U4*)(ost + row * 128 + ch * 8);
                *(GASP U4*)(O + (tok0 + qrow0 + row) * D + h * 128 + ch * 8) = v; }
        }
        __syncthreads();
    }
}

#define XB_TMO      128
#define XB_XCNT(j)  (256  + 64 * (j))
#define XB_XSUB(j)  (1280 + 64 * (j))
#define XB_XGEN(j)  (2304 + 64 * (j))
#define XB_TOP      3328
#define XB_TOPGEN   3392
#define XCD_BAR_WORDS 3456
#define XB_SPIN_CAP (1u << 18)

__device__ __forceinline__ unsigned xb_ld(unsigned* p)              { return __hip_atomic_load(p, __ATOMIC_RELAXED, __HIP_MEMORY_SCOPE_AGENT); }
__device__ __forceinline__ unsigned xb_add(unsigned* p, unsigned v) { return __hip_atomic_fetch_add(p, v, __ATOMIC_RELAXED, __HIP_MEMORY_SCOPE_AGENT); }
__device__ __forceinline__ unsigned xb_xcc_id() { return (unsigned)__builtin_amdgcn_s_getreg((3 << 11) | 20) & 0xFu; }
#define XB_SPIN(cond, bar) do { unsigned _sp = 0; while (cond) { __builtin_amdgcn_s_sleep(1); \
    if ((++_sp & 255u) == 0u) { if (xb_ld(&(bar)[XB_TMO])) break; if (_sp > XB_SPIN_CAP) { atomicAdd(&(bar)[XB_TMO], 1u); break; } } } } while (0)

struct XcdBarrier {
    unsigned* bar; unsigned x;
    volatile LAS unsigned* st;
};

__device__ __forceinline__ XcdBarrier xcd_barrier_post(unsigned* bar, volatile LAS unsigned* st, int xb_tid) {
    XcdBarrier b; b.bar = bar; b.x = xb_xcc_id(); b.st = st;
    if (xb_tid == 0) (void)xb_add(&bar[XB_XCNT(b.x)], 1u);
    return b;
}
__device__ __forceinline__ void xcd_barrier_complete(unsigned* bar, unsigned x, unsigned& nloc, unsigned& nx) {
    const unsigned G = gridDim.x * gridDim.y * gridDim.z;
    unsigned sum, cnt, mine, sp = 0u;
    for (;;) {
        sum = 0u; cnt = 0u; mine = 0u;
#pragma unroll
        for (unsigned j = 0; j < 16; ++j) { const unsigned c = xb_ld(&bar[XB_XCNT(j)]); sum += c; cnt += (c > 0u) ? 1u : 0u; mine = (j == x) ? c : mine; }
        if (sum == G) break;
        __builtin_amdgcn_s_sleep(1);
        if ((++sp & 255u) == 0u) { if (xb_ld(&bar[XB_TMO])) break; if (sp > XB_SPIN_CAP) { atomicAdd(&bar[XB_TMO], 1u); break; } }
    }
    nloc = mine > 0u ? mine : 1u; nx = cnt > 0u ? cnt : 1u;
}

__device__ __forceinline__ void xcd_barrier(const XcdBarrier& b, int xb_tid) {
    asm volatile("s_waitcnt vmcnt(0)" ::: "memory");
    __syncthreads();
    if (xb_tid == 0) {
        unsigned* bar = b.bar;
        __builtin_amdgcn_s_waitcnt(0);
        unsigned nloc = b.st[0], nx = b.st[1];
        if (nloc == 0u) { xcd_barrier_complete(bar, b.x, nloc, nx); b.st[0] = nloc; b.st[1] = nx; }
        const unsigned old = xb_add(&bar[XB_XSUB(b.x)], 1u);
        const unsigned gen = old / nloc;
        if (old + 1u == (gen + 1u) * nloc) {
            __builtin_amdgcn_fence(__ATOMIC_RELEASE, "agent");
            asm volatile("s_waitcnt vmcnt(0)" ::: "memory");
            const unsigned og = xb_add(&bar[XB_TOP], 1u);
            const unsigned tg = og / nx;
            if (og + 1u == (tg + 1u) * nx) xb_add(&bar[XB_TOPGEN], 1u);
            else XB_SPIN(xb_ld(&bar[XB_TOPGEN]) == tg, bar);
            __builtin_amdgcn_fence(__ATOMIC_ACQUIRE, "agent");
            xb_add(&bar[XB_XGEN(b.x)], 1u);
            asm volatile("s_waitcnt vmcnt(0)" ::: "memory");
        } else {
            XB_SPIN(xb_ld(&bar[XB_XGEN(b.x)]) == gen, bar);
            __builtin_amdgcn_fence(__ATOMIC_ACQUIRE, "agent");
            asm volatile("s_waitcnt vmcnt(0)" ::: "memory");
        }
    }
    __syncthreads();
}

#define GAS __attribute__((address_space(1)))
template <class Tp> __device__ __forceinline__ Tp* gptr(Tp* p) { return (Tp*)(GAS Tp*)p; }
struct Args { const float* in[20]; float* out; unsigned char* ws; };
__global__ void __launch_bounds__(NWAVES * 64, 2) mega_fwd(Args a) {
    extern __shared__ __attribute__((aligned(16))) unsigned char lds_raw[];
    LAS unsigned char* lds = (LAS unsigned char*)lds_raw;
    cg::grid_group grid = cg::this_grid();
    const int G = gridDim.x;
    const int wave0 = __builtin_amdgcn_readfirstlane((int)threadIdx.x >> 6);
    volatile LAS unsigned* xb_st = (volatile LAS unsigned*)(lds + LDS_BYTES - 16);
    if (threadIdx.x == 0) { xb_st[0] = 0u; xb_st[1] = 0u; }
    __syncthreads();
    (void)xcd_barrier_post((unsigned*)(gptr(a.ws) + WS_CTL), xb_st, (int)threadIdx.x);
#define GRID_SYNC() do { XcdBarrier xb_; unsigned char* wsb_ = a.ws; asm volatile("" : "+s"(wsb_)); xb_.bar = (unsigned*)(gptr(wsb_) + WS_CTL); xb_.x = xb_xcc_id(); xb_.st = (volatile LAS unsigned*)(lds + LDS_BYTES - 16); \
        unsigned on_ = ~0u; asm volatile("" : "+s"(on_)); xcd_barrier(xb_, wave0 * 64 + (int)__builtin_amdgcn_mbcnt_hi(on_, __builtin_amdgcn_mbcnt_lo(on_, 0u))); } while (0)
#define PHASE_IDS() unsigned ones_ = ~0u; asm volatile("" : "+s"(ones_)); int tid = wave0 * 64 + (int)__builtin_amdgcn_mbcnt_hi(ones_, __builtin_amdgcn_mbcnt_lo(ones_, 0u)); asm volatile("" : "+v"(tid)); const int lane = tid & 63, wave = wave0; \
    const int gw = blockIdx.x * NWAVES + wave, NGW = G * NWAVES; (void)gw; (void)NGW; (void)lane; \
    unsigned char* ws0_ = a.ws; asm volatile("" : "+s"(ws0_)); unsigned char* ws = gptr(ws0_); \
    bf16* XN = (bf16*)(ws + WS_XN); bf16* QO = (bf16*)(ws + WS_QO); bf16* KB = (bf16*)(ws + WS_K); bf16* VB = (bf16*)(ws + WS_V); bf16* ACT = (bf16*)(ws + WS_ACT); bf16* OB = (bf16*)(ws + WS_O); bf16* RB = (bf16*)(ws + WS_R); float* RS = (float*)(ws + WS_RS); (void)OB; (void)RB; (void)RS; \
    (void)XN; (void)QO; (void)KB; (void)VB; (void)ACT

#ifndef REP_PRO
#define REP_PRO 1
#endif
#ifndef REP_NORM
#define REP_NORM 1
#endif
#ifndef EXTRA_SYNC
#define EXTRA_SYNC 0
#endif
#pragma unroll 1
    for (int rep = 0; rep < REP_PRO; ++rep)
    {
        PHASE_IDS();
        const float* xp = gptr(a.in[0]); const float* xs = gptr(a.in[1]);
        LAS float* scr = (LAS float*)(lds + wave * 16384);
        constexpr int I_QKV = 16 * 96, I_O = 16 * 32, I_G = 16 * 88, I_D = 44 * 32, I_L = I_QKV + I_O + 2 * I_G + I_D;
#pragma unroll 1
        for (int it = gw; it < 2 * I_L; it += NGW) {
            const int L = it / I_L; int r = it % I_L;
            if (r < I_QKV) { tr_item<0, true>(L == 0 ? gptr(a.in[4]) : gptr(a.in[7]), D, NQKV, (bf16*)(ws + (L == 0 ? WS_WQKV0 : WS_WQKV1)), scr, r, lane, gptr(a.in[2]) + L * D, 1023, 1.f); continue; } r -= I_QKV;
            if (r < I_O) { tr_item<0, false>(L == 0 ? gptr(a.in[5]) : gptr(a.in[8]), D, D, (bf16*)(ws + (L == 0 ? WS_WO0 : WS_WO1)), scr, r, lane, L == 0 ? nullptr : gptr(a.in[13]), 127, 1.0f - LAMBDA_INIT); continue; } r -= I_O;
            if (r < I_G) { tr_item<1, false>(gptr(a.in[17]) + (size_t)L * D * FF, D, FF, (bf16*)(ws + (L == 0 ? WS_WGU0 : WS_WGU1)), scr, r, lane, gptr(a.in[15]) + L * D, 1023, 1.f); continue; } r -= I_G;
            if (r < I_G) { tr_item<2, false>(gptr(a.in[18]) + (size_t)L * D * FF, D, FF, (bf16*)(ws + (L == 0 ? WS_WGU0 : WS_WGU1)), scr, r, lane, gptr(a.in[15]) + L * D, 1023, 1.f); continue; } r -= I_G;
            tr_item<0, false>(gptr(a.in[19]) + (size_t)L * FF * D, FF, D, (bf16*)(ws + (L == 0 ? WS_WD0 : WS_WD1)), scr, r, lane, nullptr, 0, 1.f);
        }
#pragma unroll 1
        for (int m = gw; m < T; m += NGW) row_to_bf16_rs(m < T_P ? xp + (size_t)m * D : xs + (size_t)(m - T_P) * D, RB + (size_t)m * D, RS + m, lane);
    }
    grid.sync();
#pragma unroll 1
    for (int rep = 0; rep < EXTRA_SYNC; ++rep) GRID_SYNC();

#pragma unroll 1
    for (int L = 0; L < 2; ++L) {
#pragma unroll 1
        for (int rep = 0; rep < REP_GEMM; ++rep) {
        {   PHASE_IDS(); const bf16* Wqkv = (const bf16*)(ws + (L == 0 ? WS_WQKV0 : WS_WQKV1));
            pg8::Gemm g{RB, Wqkv, T, NQKV, D}; pg8::StaticOrder S; S.init(T, NQKV, G, (int)blockIdx.x);
            pg8::EpiQKV E{QO, (size_t)(WS_K - WS_QO) / 2, L == 0 ? 6 : 7, T, RS};
            pg8::gemm_phase<pg8::EpiQKV, pg8::StaticOrder, true, true>(lds, g, S, E, tid); }
        GRID_SYNC(); }
        if (L == 0) {
#pragma unroll 1
            for (int rep = 0; rep < REP_NA; ++rep) { { PHASE_IDS(); na_phase(lds, QO, KB, VB, OB, gptr(a.in[6]), G, wave, lane); } GRID_SYNC(); }
        } else {
#pragma unroll 1
            for (int rep = 0; rep < REP_DA; ++rep) { { PHASE_IDS(); da_phase(lds, QO, KB, VB, OB, gptr(a.in[9]), gptr(a.in[10]), gptr(a.in[11]), gptr(a.in[12]), gptr(a.in[14]), G, wave, lane, tid); } GRID_SYNC(); }
        }
#pragma unroll 1
        for (int rep = 0; rep < REP_GEMM; ++rep) {
        {   PHASE_IDS(); const bf16* Wo = (const bf16*)(ws + (L == 0 ? WS_WO0 : WS_WO1));
            pg8::Gemm g{OB, Wo, T, D, D}; pg8::StaticOrder S; S.init(T, D, G, (int)blockIdx.x);
            pg8::EpiBf16<0> E{KB, D, nullptr, 0, 0, 1.f};
            pg8::gemm_phase<pg8::EpiBf16<0>, pg8::StaticOrder, true, true>(lds, g, S, E, tid); }
        GRID_SYNC(); }
        {   PHASE_IDS(); const float* gp = gptr(a.in[3]) + L * D;
#pragma unroll 1
            for (int rep = 0; rep < REP_NORM; ++rep)
#pragma unroll 1
                for (int m = gw; m < T; m += 2 * NGW) resid_rows2<false>(KB, RB, nullptr, RS, gp, m, (m + NGW < T) ? m + NGW : m, lane);
        }
        GRID_SYNC();
#pragma unroll 1
        for (int rep = 0; rep < REP_GEMM; ++rep) {
        {   PHASE_IDS(); const bf16* Wgu = (const bf16*)(ws + (L == 0 ? WS_WGU0 : WS_WGU1));
            pg8::Gemm g{RB, Wgu, T, 2 * FF, D}; pg8::StaticOrder S; S.init(T, 2 * FF, G, (int)blockIdx.x);
            pg8::EpiSwiglu E{ACT, FF, RS};
            pg8::gemm_phase<pg8::EpiSwiglu, pg8::StaticOrder, true, true>(lds, g, S, E, tid); }
        GRID_SYNC(); }
#pragma unroll 1
        for (int rep = 0; rep < REP_GEMM; ++rep) {
        {   PHASE_IDS(); const bf16* Wd = (const bf16*)(ws + (L == 0 ? WS_WD0 : WS_WD1));
            pg8::Gemm g{ACT, Wd, T, D, FF}; pg8::StaticOrder S; S.init(T, D, G, (int)blockIdx.x);
            pg8::EpiBf16<0> E{XN, D, nullptr, 0, 0, 1.f};
            pg8::gemm_phase<pg8::EpiBf16<0>, pg8::StaticOrder, true, true>(lds, g, S, E, tid); }
        GRID_SYNC(); }
        {   PHASE_IDS(); float* out = gptr(a.out); const float* gp = gptr(a.in[16]) + L * D;
            if (L == 0) {
#pragma unroll 1
                for (int m = gw; m < T; m += 2 * NGW) resid_rows2<false>(XN, RB, nullptr, RS, gp, m, (m + NGW < T) ? m + NGW : m, lane);
            } else {
#pragma unroll 1
                for (int m = gw; m < T; m += 2 * NGW) resid_rows2<true>(XN, RB, out, RS, gp, m, (m + NGW < T) ? m + NGW : m, lane);
            } }
        if (L == 0) GRID_SYNC();
    }
}

extern "C" void kernel_launch(void* const* d_in, const int* in_sizes, int n_in, void* d_out, int out_size, void* d_ws, size_t ws_size, hipStream_t stream) {
    static int grid = 0;
    if (grid == 0) {
        if (n_in != 20 || out_size != T * D || ws_size < WS_END) { fprintf(stderr, "kernel_launch: unexpected problem (n_in %d, out %d, ws %zu)\n", n_in, out_size, ws_size); grid = -1; return; }
        int dev = 0, cus = 0, per_cu = 0;
        if (hipGetDevice(&dev) != hipSuccess || hipDeviceGetAttribute(&cus, hipDeviceAttributeMultiprocessorCount, dev) != hipSuccess) { grid = -1; return; }
        if (hipFuncSetAttribute((const void*)mega_fwd, hipFuncAttributeMaxDynamicSharedMemorySize, LDS_BYTES) != hipSuccess) { fprintf(stderr, "kernel_launch: hipFuncSetAttribute failed\n"); grid = -1; return; }
        if (hipOccupancyMaxActiveBlocksPerMultiprocessor(&per_cu, (const void*)mega_fwd, NWAVES * 64, LDS_BYTES) != hipSuccess || per_cu < 1) { fprintf(stderr, "kernel_launch: occupancy query says %d\n", per_cu); (void)hipGetLastError(); per_cu = 1; }
        grid = cus * per_cu;
    }
    if (grid < 0) return;
    Args a{};
    for (int i = 0; i < 20; ++i) a.in[i] = (const float*)d_in[i];
    a.out = (float*)d_out; a.ws = (unsigned char*)d_ws;
    if (hipMemsetAsync((char*)d_ws + WS_CTL, 0, CTL_BYTES, stream) != hipSuccess) { fprintf(stderr, "kernel_launch: hipMemsetAsync failed\n"); return; }
    void* args[] = {&a};
    hipError_t e = hipLaunchCooperativeKernel((const void*)mega_fwd, dim3(grid), dim3(NWAVES * 64), args, LDS_BYTES, stream);
    if (e != hipSuccess) fprintf(stderr, "kernel_launch: cooperative launch failed: %s (grid %d)\n", hipGetErrorString(e), grid);
}
```
